# Optimizing an MI355X kernel written in HIP

```python
import jax, jax.numpy as jnp
from jax import lax
import numpy as np

D_MODEL = 4096
BATCH = 32
SEQ = 256
DEPTH = 2
DEC_BATCH = 8
DEC_SEQ = 1024
PAST_LEN = 512

GRID_W = 64
HEAD_DIM = 128
A_Q_HEADS = D_MODEL // (2 * HEAD_DIM)
A_KV_HEADS = A_Q_HEADS // 4
A_GROUPS = A_Q_HEADS // A_KV_HEADS
A_HALF_WIN = 128
A_BLOCK = 128
B_HEADS = D_MODEL // (2 * HEAD_DIM)
B_WIN_ROWS = 8
B_WIN_COLS = 16
A_WIDTH = A_Q_HEADS * HEAD_DIM
A_KV_WIDTH = A_KV_HEADS * HEAD_DIM
B_WIDTH = B_HEADS * HEAD_DIM
MIX_WIDTH = A_WIDTH + B_WIDTH
ATTN_SPLITS = (A_WIDTH, A_KV_WIDTH, A_KV_WIDTH, B_WIDTH, B_WIDTH, B_WIDTH, MIX_WIDTH)
ATTN_IN_WIDTH = sum(ATTN_SPLITS)
POOL_WINDOWS = (2, 4, 8, 16)
N_POOL_GROUPS = 4
POOL_WIDTH = D_MODEL
POOL_GROUP = POOL_WIDTH // N_POOL_GROUPS
ROPE_BASE = 10000.0
NORM_EPS = 1e-6
NEG_INF = -1e30
N_ATTN_LAYERS = (DEPTH + 1) // 2
N_POOL_LAYERS = DEPTH // 2

kernel_name = 'hybrid_diffusion_prefix_ctx_step'

F32 = jnp.float32


def rmsnorm(x, g):
    xf = x.astype(F32)
    y = xf * lax.rsqrt(jnp.mean(xf * xf, axis=-1, keepdims=True) + NORM_EPS) * g.astype(F32)
    return y.astype(x.dtype)


def split_cols(a, widths):
    idx = [int(i) for i in np.cumsum(widths)[:-1]]
    return jnp.split(a, idx, axis=-1)


def axial_rope(n):
    t = jnp.arange(n)
    quarter = HEAD_DIM // 4
    inv_freq = ROPE_BASE ** (-jnp.arange(quarter, dtype=F32) / quarter)
    ang_r = (t // GRID_W).astype(F32)[:, None] * inv_freq
    ang_c = (t % GRID_W).astype(F32)[:, None] * inv_freq
    ang = jnp.concatenate([ang_r, ang_r, ang_c, ang_c], axis=-1)
    return jnp.cos(ang), jnp.sin(ang)


def apply_rope(x, cos, sin):
    quarter = HEAD_DIM // 4
    xr = x.reshape(x.shape[:-1] + (2, 2, quarter))
    rot = jnp.stack([-xr[..., 1, :], xr[..., 0, :]], axis=-2).reshape(x.shape)
    out = x.astype(F32) * cos[None, :, None, :] + rot.astype(F32) * sin[None, :, None, :]
    return out.astype(x.dtype)


def dense_attention(q, k, v, sink):
    b, n, hq, _ = q.shape
    kv = k.shape[2]
    g = hq // kv
    qg = q.reshape(b, n, kv, g, HEAD_DIM)
    s = jnp.einsum('bqkgd,bjkd->bkgqj', qg, k).astype(F32) * (HEAD_DIM ** -0.5)
    if sink is not None:
        s_sink = jnp.broadcast_to(sink.astype(F32).reshape(kv, g, 1, 1), s.shape[:-1] + (1,))
        s = jnp.concatenate([s, s_sink], axis=-1)
    p = jax.nn.softmax(s, axis=-1)[..., :n].astype(v.dtype)
    o = jnp.einsum('bkgqj,bjkd->bqkgd', p, v)
    return o.reshape(b, n, hq * HEAD_DIM)


def window_attention(q, k, v, ck, cv, sink):
    b, n = q.shape[:2]
    nb = n // A_BLOCK
    ctx_len = ck.shape[1]
    span = 3 * A_BLOCK
    scale = HEAD_DIM ** -0.5

    def band(t):
        tp = jnp.pad(t, ((0, 0), (A_BLOCK, A_BLOCK), (0, 0), (0, 0)))
        tp = tp.reshape(b, nb + 2, A_BLOCK, A_KV_HEADS, HEAD_DIM)
        return jnp.concatenate([tp[:, :nb], tp[:, 1:nb + 1], tp[:, 2:]], axis=2)

    kb, vb = band(k), band(v)
    qb = q.reshape(b, nb, A_BLOCK, A_KV_HEADS, A_GROUPS, HEAD_DIM)
    s_win = jnp.einsum('bnqkgd,bnjkd->bkgnqj', qb, kb).astype(F32) * scale
    qpos = jnp.arange(n).reshape(nb, A_BLOCK)
    kpos = jnp.arange(nb)[:, None] * A_BLOCK - A_BLOCK + jnp.arange(span)[None, :]
    valid = ((jnp.abs(qpos[:, :, None] - kpos[:, None, :]) <= A_HALF_WIN)
             & (kpos[:, None, :] >= 0) & (kpos[:, None, :] < n))
    s_win = jnp.where(valid, s_win, NEG_INF)
    s_ctx = jnp.einsum('bnqkgd,bjkd->bkgnqj', qb, ck).astype(F32) * scale
    s_sink = jnp.broadcast_to(sink.astype(F32).reshape(A_KV_HEADS, A_GROUPS, 1, 1, 1),
                              s_win.shape[:-1] + (1,))
    p = jax.nn.softmax(jnp.concatenate([s_win, s_ctx, s_sink], axis=-1), axis=-1)
    p_win = p[..., :span].astype(v.dtype)
    p_ctx = p[..., span:span + ctx_len].astype(v.dtype)
    o = (jnp.einsum('bkgnqj,bnjkd->bnqkgd', p_win, vb)
         + jnp.einsum('bkgnqj,bjkd->bnqkgd', p_ctx, cv))
    return o.reshape(b, n, A_Q_HEADS * HEAD_DIM)


def neighbourhood_attention(q, k, v, ck, cv, rpb):
    b, n = q.shape[:2]
    rows = n // GRID_W
    wr = min(B_WIN_ROWS, rows)
    kw = wr * GRID_W
    scale = HEAD_DIM ** -0.5
    r = jnp.arange(rows)
    row_start = jnp.clip(r - wr // 2, 0, rows - wr)
    row_idx = row_start[:, None] + jnp.arange(wr)[None, :]

    def gather_rows(t):
        tg = t.reshape(b, rows, GRID_W, B_HEADS, HEAD_DIM)[:, row_idx]
        return tg.reshape(b, rows, kw, B_HEADS, HEAD_DIM)

    kg, vg = gather_rows(k), gather_rows(v)
    qg = q.reshape(b, rows, GRID_W, B_HEADS, HEAD_DIM)
    s_nb = jnp.einsum('brchd,brjhd->bhrcj', qg, kg).astype(F32) * scale
    col = jnp.arange(GRID_W)
    col_start = jnp.clip(col - B_WIN_COLS // 2, 0, GRID_W - B_WIN_COLS)
    key_col = jnp.broadcast_to(col, (wr, GRID_W)).reshape(kw)
    key_row = jnp.repeat(row_idx, GRID_W, axis=1)
    col_ok = ((key_col[None, :] >= col_start[:, None])
              & (key_col[None, :] < col_start[:, None] + B_WIN_COLS))
    dr = jnp.clip(key_row - r[:, None] + B_WIN_ROWS - 1, 0, 2 * B_WIN_ROWS - 2)
    dc = jnp.clip(key_col[None, :] - col[:, None] + B_WIN_COLS - 1, 0, 2 * B_WIN_COLS - 2)
    bias = rpb[:, dr[:, None, :], dc[None, :, :]].astype(F32)
    s_nb = jnp.where(col_ok[None, None, None], s_nb + bias[None], NEG_INF)
    s_ctx = jnp.einsum('brchd,bjhd->bhrcj', qg, ck).astype(F32) * scale
    p = jax.nn.softmax(jnp.concatenate([s_nb, s_ctx], axis=-1), axis=-1)
    p_nb = p[..., :kw].astype(v.dtype)
    p_ctx = p[..., kw:].astype(v.dtype)
    o = (jnp.einsum('bhrcj,brjhd->brchd', p_nb, vg)
         + jnp.einsum('bhrcj,bjhd->brchd', p_ctx, cv))
    return o.reshape(b, n, B_HEADS * HEAD_DIM)


def attn_project(h, w_in):
    b, n = h.shape[:2]
    qa, ka, va, qb, kb, vb, gate = split_cols(h @ w_in, ATTN_SPLITS)
    heads = lambda t, nh: t.reshape(b, n, nh, HEAD_DIM)
    return (heads(qa, A_Q_HEADS), heads(ka, A_KV_HEADS), heads(va, A_KV_HEADS),
            heads(qb, B_HEADS), heads(kb, B_HEADS), heads(vb, B_HEADS), gate)


def attn_layer_context(h, w_in, sink, w_out):
    qa, ka, va, qb, kb, vb, gate = attn_project(h, w_in)
    oa = dense_attention(qa, ka, va, sink)
    ob = dense_attention(qb, kb, vb, None)
    o = jnp.concatenate([oa, ob], axis=-1) * jax.nn.silu(gate)
    return o @ w_out, ka, va, kb, vb


def attn_layer_latent(h, w_in, sink, rpb, w_out, ck_a, cv_a, ck_b, cv_b):
    qa, ka, va, qb, kb, vb, gate = attn_project(h, w_in)
    cos, sin = axial_rope(h.shape[1])
    qa = apply_rope(qa, cos, sin)
    ka = apply_rope(ka, cos, sin)
    oa = window_attention(qa, ka, va, ck_a, cv_a, sink)
    ob = neighbourhood_attention(qb, kb, vb, ck_b, cv_b, rpb)
    o = jnp.concatenate([oa, ob], axis=-1) * jax.nn.silu(gate)
    return o @ w_out


def pool_mixer(h, w_in, w_grp, scale, w_out):
    b, n = h.shape[:2]
    u, gate = jnp.split(h @ w_in, 2, axis=-1)
    ug = u.reshape(b, n, N_POOL_GROUPS, POOL_GROUP)
    cs = jnp.concatenate([jnp.zeros((b, 1, N_POOL_GROUPS, POOL_GROUP), F32),
                          jnp.cumsum(ug.astype(F32), axis=1)], axis=1)
    half = jnp.array(POOL_WINDOWS, dtype=jnp.int32) // 2
    t = jnp.arange(n)[:, None]
    lo = jnp.clip(t - half[None, :], 0, n)
    hi = jnp.clip(t + half[None, :], 0, n)
    gi = jnp.arange(N_POOL_GROUPS)[None, :]
    mean = (cs[:, hi, gi] - cs[:, lo, gi]) / (hi - lo).astype(F32)[None, :, :, None]
    pooled = mean.astype(u.dtype) - ug
    y = jnp.einsum('bngc,gcd->bngd', pooled, w_grp).reshape(b, n, POOL_WIDTH) * scale
    return (y * jax.nn.silu(gate)) @ w_out


def setup_inputs(seed: int = 0) -> dict:
    key = jax.random.key(seed)
    ks = jax.random.split(key, 20)
    nrm = lambda k, shape, s: jax.random.normal(k, shape, F32) * s
    d = D_MODEL
    return {
        'x_prompt': nrm(ks[0], (BATCH, SEQ, d), 1.0),
        'x_sample': nrm(ks[1], (DEC_BATCH, DEC_SEQ, d), 1.0),
        'c': nrm(ks[2], (DEC_BATCH, d), 1.0),
        'cache_a_k': nrm(ks[3], (DEC_BATCH, N_ATTN_LAYERS, PAST_LEN, A_KV_HEADS, HEAD_DIM), 1.0),
        'cache_a_v': nrm(ks[4], (DEC_BATCH, N_ATTN_LAYERS, PAST_LEN, A_KV_HEADS, HEAD_DIM), 1.0),
        'cache_b_k': nrm(ks[5], (DEC_BATCH, N_ATTN_LAYERS, PAST_LEN, B_HEADS, HEAD_DIM), 1.0),
        'cache_b_v': nrm(ks[6], (DEC_BATCH, N_ATTN_LAYERS, PAST_LEN, B_HEADS, HEAD_DIM), 1.0),
        'c_ctx': nrm(ks[7], (d,), 1.0),
        'w_ada': nrm(ks[8], (DEPTH, d, 3 * d), 0.5 * d ** -0.5),
        'b_ada': nrm(ks[9], (DEPTH, 3 * d), 0.02),
        'norm_g': 1.0 + nrm(ks[10], (DEPTH, d), 0.02),
        'w_in_attn': nrm(ks[11], (N_ATTN_LAYERS, d, ATTN_IN_WIDTH), d ** -0.5),
        'a_sink': nrm(ks[12], (N_ATTN_LAYERS, A_Q_HEADS), 0.5),
        'b_rpb': nrm(ks[13], (N_ATTN_LAYERS, B_HEADS, 2 * B_WIN_ROWS - 1, 2 * B_WIN_COLS - 1), 0.1),
        'w_out_attn': nrm(ks[14], (N_ATTN_LAYERS, MIX_WIDTH, d), MIX_WIDTH ** -0.5),
        'w_in_pool': nrm(ks[15], (N_POOL_LAYERS, d, 2 * POOL_WIDTH), d ** -0.5),
        'w_grp_pool': nrm(ks[16], (N_POOL_LAYERS, N_POOL_GROUPS, POOL_GROUP, POOL_GROUP), POOL_GROUP ** -0.5),
        'pool_scale': 1.0 + nrm(ks[17], (N_POOL_LAYERS, POOL_WIDTH), 0.02),
        'w_out_pool': nrm(ks[18], (N_POOL_LAYERS, POOL_WIDTH, d), POOL_WIDTH ** -0.5),
        'final_g': 1.0 + nrm(ks[19], (d,), 0.02),
    }


def reference(x_prompt, x_sample, c, cache_a_k, cache_a_v, cache_b_k, cache_b_v, c_ctx,
              w_ada, b_ada, norm_g, w_in_attn, a_sink, b_rpb, w_out_attn,
              w_in_pool, w_grp_pool, pool_scale, w_out_pool, final_g):
    xp, xs = x_prompt, x_sample
    cond_ctx = jax.nn.silu(c_ctx)
    cond_lat = jax.nn.silu(c)
    new_ak, new_av, new_bk, new_bv = [], [], [], []
    for layer in range(DEPTH):
        m_ctx = cond_ctx @ w_ada[layer] + b_ada[layer]
        m_lat = cond_lat @ w_ada[layer] + b_ada[layer]
        sh_c, sc_c, g_c = jnp.split(m_ctx, 3, axis=-1)
        sh_l, sc_l, g_l = jnp.split(m_lat[:, None, :], 3, axis=-1)
        hp = rmsnorm(xp, norm_g[layer]) * (1.0 + sc_c) + sh_c
        hs = rmsnorm(xs, norm_g[layer]) * (1.0 + sc_l) + sh_l
        i = layer // 2
        if layer % 2 == 0:
            out_p, ka, va, kb, vb = attn_layer_context(hp, w_in_attn[i], a_sink[i], w_out_attn[i])
            new_ak.append(ka)
            new_av.append(va)
            new_bk.append(kb)
            new_bv.append(vb)
            out_s = attn_layer_latent(hs, w_in_attn[i], a_sink[i], b_rpb[i], w_out_attn[i],
                                      cache_a_k[:, i], cache_a_v[:, i],
                                      cache_b_k[:, i], cache_b_v[:, i])
        else:
            out_p = pool_mixer(hp, w_in_pool[i], w_grp_pool[i], pool_scale[i], w_out_pool[i])
            out_s = pool_mixer(hs, w_in_pool[i], w_grp_pool[i], pool_scale[i], w_out_pool[i])
        xp = xp + g_c * out_p
        xs = xs + g_l * out_s
    y_prompt = rmsnorm(xp, final_g)
    y_sample = rmsnorm(xs, final_g)
    new_a_k = jnp.stack(new_ak, axis=1)
    new_a_v = jnp.stack(new_av, axis=1)
    new_b_k = jnp.stack(new_bk, axis=1)
    new_b_v = jnp.stack(new_bv, axis=1)
    return (y_prompt, y_sample, new_a_k, new_a_v, new_b_k, new_b_v)
```

```cpp
#include <hip/hip_runtime.h>
#include <cstdio>
#include <cstdint>

#ifndef MK_N_LAUNCHES
#define MK_N_LAUNCHES 1
#endif

namespace pg8 {
#define PG8_LAS __attribute__((address_space(3)))
typedef unsigned short bf16_t;
typedef short bf16x8 __attribute__((ext_vector_type(8)));
typedef float f32x4 __attribute__((ext_vector_type(4)));
typedef unsigned u32x4 __attribute__((ext_vector_type(4)));
typedef int i32x4 __attribute__((ext_vector_type(4)));
typedef int i32x8 __attribute__((ext_vector_type(8)));
constexpr int BM = 256, BK = 64, HALF = 128, HTB = HALF * BK * 2  , STAGE_BYTES = 8 * HTB, NXCD = 8, WGM = 4;

__host__ __device__ __forceinline__ int lds_byte(int r, int c) { const int st = (r >> 4) * 2 + (c >> 5), rr = r & 15, cc = c & 31, ob = rr * 64 + cc * 2; return st * 1024 + (ob ^ (((ob >> 9) & 1) << 5)); }
__host__ __device__ __forceinline__ void stage_rc(int b, int& R, int& C) { const int st = b / 1024, sb = b % 1024, swz = sb ^ (((sb >> 9) & 1) << 5); R = (st >> 1) * 16 + swz / 64; C = (st & 1) * 32 + (swz % 64) / 2; }
__host__ __device__ __forceinline__ int perm32(int rho) { const int n = rho >> 4, i = rho & 15; return 8 * (i >> 2) + 4 * n + (i & 3); }

struct Unit { int pm, pn; };
struct Gemm { const bf16_t* A; const bf16_t* Bt; int M, N, K, lda, ldb, agrp, bgrp; };

struct StaticOrder {
    int nM, nN, nwg, G, c;
    __host__ __device__ void init(int M, int N, int G_, int c_) { nM = M / BM; nN = N / BM; nwg = nM * nN; G = G_; c = c_; }
    __host__ __device__ bool next(int i, Unit& u) const {
        const long L = (long)i * G + c; if (L >= nwg) return false;
        if (nM % 16 == 0 && nN % 2 == 0) {
            const int xcd = (int)(L % NXCD), off = (int)(L / NXCD), xr = xcd >> 1, xc = xcd & 1, nh = nN >> 1, sg = off / (4 * nh), r = off % (4 * nh);
            u.pm = (nM >> 2) * xr + 4 * sg + (r & 3); u.pn = xc * nh + (r >> 2); return true;
        }
        int wgid = (int)L; { const int q = nwg / NXCD, r = nwg % NXCD, xcd = wgid % NXCD, off = wgid / NXCD; wgid = (xcd < r ? xcd * (q + 1) : r * (q + 1) + (xcd - r) * q) + off; }
        const int nig = WGM * nN, gid = wgid / nig, fm = gid * WGM, gsz = (nM - fm) < WGM ? (nM - fm) : WGM;
        u.pm = fm + ((wgid % nig) % gsz); u.pn = (wgid % nig) / gsz; return true;
    }
    __device__ __forceinline__ void a_ready(const Unit&) const {}
    __device__ __forceinline__ void done(const Unit&) const {}
};

struct MixedOrder {
    StaticOrder L, C; int G, c;
    __host__ __device__ void init(int G_, int c_) { G = G_; c = c_; L.init(8192, 13312, 1, 0); C.init(8192, 8192, 1, 0); }
    __host__ __device__ bool next(int i, Unit& u) const {
        int idx;
        if (G == 256) { if (i < 9) idx = i * 256 + c; else if (c < 128 && i < 12) idx = 2304 + (i - 9) * 128 + c; else return false; }
        else idx = i * G + c;
        if (idx < L.nwg) { L.next(idx, u); u.pm += 32; return true; }
        const int j = idx - L.nwg; if (j >= C.nwg) return false;
        C.next(j, u); u.pn = u.pn < 8 ? u.pn : (u.pn < 16 ? u.pn + 4 : u.pn + 20); return true;
    }
    __device__ __forceinline__ void a_ready(const Unit&) const {}
    __device__ __forceinline__ void done(const Unit&) const {}
};
__device__ __forceinline__ unsigned cvt_pk_bf16(float lo, float hi) { unsigned r; asm volatile("v_cvt_pk_bf16_f32 %0, %1, %2" : "=v"(r) : "v"(lo), "v"(hi)); return r; }
__device__ __forceinline__ float bf_lo(unsigned w) { return __uint_as_float(w << 16); }
__device__ __forceinline__ float bf_hi(unsigned w) { return __uint_as_float(w & 0xffff0000u); }
__device__ __forceinline__ float silu_f(float x) { return x * __builtin_amdgcn_rcpf(1.0f + __builtin_amdgcn_exp2f(-1.4426950408889634f * x)); }

struct EpiBf16 {
    static constexpr bool PERM = true, AFTER_DRAIN = false;
    bf16_t* O; int ldc; size_t bst; float mul;
    __device__ __forceinline__ void operator()(const f32x4 (&acc)[2][2][4][2], const Unit& u, int wr, int wc, int fr, int fq) const {
        const int row0 = u.pm * BM + wr * 64 + fr, col0 = wc * 32 + 8 * fq;
        bf16_t* Ot = O + (size_t)(2 * u.pn) * bst + col0;
#pragma unroll
        for (int ai = 0; ai < 2; ++ai)
#pragma unroll
            for (int m = 0; m < 4; ++m) { bf16_t* rowp = Ot + (size_t)(row0 + ai * HALF + m * 16) * ldc;
#pragma unroll
                for (int bj = 0; bj < 2; ++bj) { const f32x4 v0 = acc[ai][bj][m][0] * mul, v1 = acc[ai][bj][m][1] * mul;
                    u32x4 w; w.x = cvt_pk_bf16(v0[0], v0[1]); w.y = cvt_pk_bf16(v0[2], v0[3]); w.z = cvt_pk_bf16(v1[0], v1[1]); w.w = cvt_pk_bf16(v1[2], v1[3]);
                    *(u32x4*)(rowp + bj * bst) = w; } }
    }
};
constexpr int ROPE_LD = 36;
struct EpiQKVG {
    static constexpr bool PERM = true, AFTER_DRAIN = false;
    bf16_t* O; int ldc; size_t bst; float mul; const PG8_LAS float* tab;
    __device__ __forceinline__ void operator()(const f32x4 (&acc)[2][2][4][2], const Unit& u, int wr, int wc, int fr, int fq) const {
        const int row0 = u.pm * BM + wr * 64 + fr;
        if (u.pn >= 10) {
            bf16_t* Ot = O + (size_t)(2 * u.pn) * bst + wc * 32 + 8 * fq;
#pragma unroll
            for (int ai = 0; ai < 2; ++ai)
#pragma unroll
                for (int m = 0; m < 4; ++m) { bf16_t* rowp = Ot + (size_t)(row0 + ai * HALF + m * 16) * ldc;
#pragma unroll
                    for (int bj = 0; bj < 2; ++bj) { const f32x4 v0 = acc[ai][bj][m][0] * mul, v1 = acc[ai][bj][m][1] * mul;
                        u32x4 w; w.x = cvt_pk_bf16(v0[0], v0[1]); w.y = cvt_pk_bf16(v0[2], v0[3]); w.z = cvt_pk_bf16(v1[0], v1[1]); w.w = cvt_pk_bf16(v1[2], v1[3]);
                        *(u32x4*)(rowp + bj * bst) = w; } }
            return;
        }
        const bool rot = u.pm >= 32; const int blk = wc & 1, i0 = 8 * fq;
        bf16_t* Ot = O + (size_t)(2 * u.pn + (wc >> 1)) * bst + blk * 64 + i0;
        f32x4 c0 = (f32x4){mul, mul, mul, mul}, c1 = c0, s0 = (f32x4){0.f, 0.f, 0.f, 0.f}, s1 = s0;
#define PG8_ROPE_LOAD(pos) do { const PG8_LAS float* tp = tab + (pos) * ROPE_LD + i0; c0 = *(const PG8_LAS f32x4*)tp * mul; c1 = *(const PG8_LAS f32x4*)(tp + 4) * mul; \
            s0 = *(const PG8_LAS f32x4*)(tp + 64 * ROPE_LD) * mul; s1 = *(const PG8_LAS f32x4*)(tp + 64 * ROPE_LD + 4) * mul; } while (0)
#define PG8_ROPE_ROW(ai, m) do { const int row = row0 + (ai) * HALF + (m) * 16; \
            const f32x4 l0 = acc[ai][0][m][0], l1 = acc[ai][0][m][1], h0 = acc[ai][1][m][0], h1 = acc[ai][1][m][1]; \
            const f32x4 a0 = l0 * c0 - h0 * s0, a1 = l1 * c1 - h1 * s1, b0 = h0 * c0 + l0 * s0, b1 = h1 * c1 + l1 * s1; \
            u32x4 wa, wb; wa.x = cvt_pk_bf16(a0[0], a0[1]); wa.y = cvt_pk_bf16(a0[2], a0[3]); wa.z = cvt_pk_bf16(a1[0], a1[1]); wa.w = cvt_pk_bf16(a1[2], a1[3]); \
            wb.x = cvt_pk_bf16(b0[0], b0[1]); wb.y = cvt_pk_bf16(b0[2], b0[3]); wb.z = cvt_pk_bf16(b1[0], b1[1]); wb.w = cvt_pk_bf16(b1[2], b1[3]); \
            bf16_t* rowp = Ot + (size_t)row * ldc; *(u32x4*)rowp = wa; *(u32x4*)(rowp + 32) = wb; } while (0)
        if (!rot || blk == 0) {
#pragma unroll
            for (int ai = 0; ai < 2; ++ai) {
                if (rot) PG8_ROPE_LOAD(((row0 + ai * HALF) & 1023) >> 6);
#pragma unroll
                for (int m = 0; m < 4; ++m) PG8_ROPE_ROW(ai, m);
            }
        } else {
#pragma unroll
            for (int m = 0; m < 4; ++m) {
                PG8_ROPE_LOAD((row0 + m * 16) & 63);
#pragma unroll
                for (int ai = 0; ai < 2; ++ai) PG8_ROPE_ROW(ai, m);
            }
        }
#undef PG8_ROPE_LOAD
#undef PG8_ROPE_ROW
    }
};
struct EpiKV {
    static constexpr bool PERM = true, AFTER_DRAIN = false;
    bf16_t* O; int ldc; size_t bst; float* nak; float* nav; float* nbk; float* nbv;
    __device__ __forceinline__ void operator()(const f32x4 (&acc)[2][2][4][2], const Unit& u, int wr, int wc, int fr, int fq) const {
        const int pn = u.pn, colt = pn < 4 ? 2048 + 256 * pn : 5120 + 256 * (pn - 4);
        const int row0 = u.pm * BM + wr * 64 + fr, col0 = wc * 32 + 8 * fq;
        bf16_t* Ot = O + (size_t)(colt >> 7) * bst + col0;
        float* fdst; int fld;
        if (pn < 2)       { fdst = nak + pn * 256;        fld = 512; }
        else if (pn < 4)  { fdst = nav + (pn - 2) * 256;  fld = 512; }
        else if (pn < 12) { fdst = nbk + (pn - 4) * 256;  fld = 2048; }
        else              { fdst = nbv + (pn - 12) * 256; fld = 2048; }
#pragma unroll
        for (int ai = 0; ai < 2; ++ai)
#pragma unroll
            for (int m = 0; m < 4; ++m) { const int row = row0 + ai * HALF + m * 16; bf16_t* rowp = Ot + (size_t)row * ldc;
#pragma unroll
                for (int bj = 0; bj < 2; ++bj) { const f32x4 v0 = acc[ai][bj][m][0], v1 = acc[ai][bj][m][1];
                    u32x4 w; w.x = cvt_pk_bf16(v0[0], v0[1]); w.y = cvt_pk_bf16(v0[2], v0[3]); w.z = cvt_pk_bf16(v1[0], v1[1]); w.w = cvt_pk_bf16(v1[2], v1[3]);
                    *(u32x4*)(rowp + bj * bst) = w;
                    float* fp = fdst + (size_t)row * fld + wc * 32 + 8 * fq + bj * HALF; *(f32x4*)fp = v0; *(f32x4*)(fp + 4) = v1; } }
    }
};
template <class TB, class TO, bool I8> struct EpiResT {
    static constexpr bool PERM = true, AFTER_DRAIN = false;
    const TB* baseP; const TB* baseS; TO* out; int ldc; const float* gate; float mul; const float* sa; const float* sb;
    __device__ __forceinline__ void operator()(const f32x4 (&acc)[2][2][4][2], const Unit& u, int wr, int wc, int fr, int fq) const {
        const int row0 = u.pm * BM + wr * 64 + fr, col0 = u.pn * BM + wc * 32 + 8 * fq;
        const int j = u.pm < 32 ? 0 : 1 + ((u.pm - 32) >> 2);
        const float* gv = gate + (size_t)j * 12288 + col0;
        const TB* bp = u.pm < 32 ? baseP + (size_t)row0 * ldc : baseS + (size_t)(row0 - 8192) * ldc;
        f32x4 g4[2][2];
#pragma unroll
        for (int bj = 0; bj < 2; ++bj)
#pragma unroll
            for (int n = 0; n < 2; ++n) { g4[bj][n] = *(const f32x4*)(gv + bj * HALF + 4 * n); if constexpr (I8) g4[bj][n] = g4[bj][n] * *(const f32x4*)(sb + col0 + bj * HALF + 4 * n); else g4[bj][n] = g4[bj][n] * mul; }
#pragma unroll
        for (int ai = 0; ai < 2; ++ai)
#pragma unroll
            for (int m = 0; m < 4; ++m) { const size_t ro = (size_t)(ai * HALF + m * 16) * ldc + col0; TO* op = out + (size_t)row0 * ldc + ro; const TB* ip = bp + ro;
                float sr = 1.0f; if constexpr (I8) sr = sa[row0 + ai * HALF + m * 16];
#pragma unroll
                for (int bj = 0; bj < 2; ++bj) { f32x4 b0, b1;
                    if constexpr (sizeof(TB) == 4) { b0 = *(const f32x4*)(ip + bj * HALF); b1 = *(const f32x4*)(ip + bj * HALF + 4); }
                    else { const u32x4 w = *(const u32x4*)(ip + bj * HALF); b0 = (f32x4){bf_lo(w.x), bf_hi(w.x), bf_lo(w.y), bf_hi(w.y)}; b1 = (f32x4){bf_lo(w.z), bf_hi(w.z), bf_lo(w.w), bf_hi(w.w)}; }
                    f32x4 a0, a1;
                    if constexpr (I8) { a0 = __builtin_convertvector(__builtin_bit_cast(i32x4, acc[ai][bj][m][0]), f32x4) * sr; a1 = __builtin_convertvector(__builtin_bit_cast(i32x4, acc[ai][bj][m][1]), f32x4) * sr; }
                    else { a0 = acc[ai][bj][m][0]; a1 = acc[ai][bj][m][1]; }
                    const f32x4 v0 = b0 + g4[bj][0] * a0, v1 = b1 + g4[bj][1] * a1;
                    if constexpr (sizeof(TO) == 4) { *(f32x4*)(op + bj * HALF) = v0; *(f32x4*)(op + bj * HALF + 4) = v1; }
                    else { u32x4 w; w.x = cvt_pk_bf16(v0[0], v0[1]); w.y = cvt_pk_bf16(v0[2], v0[3]); w.z = cvt_pk_bf16(v1[0], v1[1]); w.w = cvt_pk_bf16(v1[2], v1[3]); *(u32x4*)(op + bj * HALF) = w; } }
                asm volatile("" ::: "memory"); }
    }
};
struct EpiPool {
    static constexpr bool PERM = true, AFTER_DRAIN = false;
    bf16_t* O; int ldc; const bf16_t* G; int ldg; const float* scale;
    __device__ __forceinline__ void operator()(const f32x4 (&acc)[2][2][4][2], const Unit& u, int wr, int wc, int fr, int fq) const {
        const int row0 = u.pm * BM + wr * 64 + fr, col0 = u.pn * BM + wc * 32 + 8 * fq;
        f32x4 sc[2][2];
#pragma unroll
        for (int bj = 0; bj < 2; ++bj)
#pragma unroll
            for (int n = 0; n < 2; ++n) sc[bj][n] = *(const f32x4*)(scale + col0 + bj * HALF + 4 * n);
#pragma unroll
        for (int ai = 0; ai < 2; ++ai)
#pragma unroll
            for (int m = 0; m < 4; ++m) { const int row = row0 + ai * HALF + m * 16; bf16_t* rowp = O + (size_t)row * ldc + col0; const bf16_t* gp = G + (size_t)row * ldg + col0;
#pragma unroll
                for (int bj = 0; bj < 2; ++bj) { const u32x4 gw = *(const u32x4*)(gp + bj * HALF);
                    f32x4 v0 = acc[ai][bj][m][0] * sc[bj][0], v1 = acc[ai][bj][m][1] * sc[bj][1];
                    v0[0] *= silu_f(bf_lo(gw.x)); v0[1] *= silu_f(bf_hi(gw.x)); v0[2] *= silu_f(bf_lo(gw.y)); v0[3] *= silu_f(bf_hi(gw.y));
                    v1[0] *= silu_f(bf_lo(gw.z)); v1[1] *= silu_f(bf_hi(gw.z)); v1[2] *= silu_f(bf_lo(gw.w)); v1[3] *= silu_f(bf_hi(gw.w));
                    u32x4 w; w.x = cvt_pk_bf16(v0[0], v0[1]); w.y = cvt_pk_bf16(v0[2], v0[3]); w.z = cvt_pk_bf16(v1[0], v1[1]); w.w = cvt_pk_bf16(v1[2], v1[3]);
                    *(u32x4*)(rowp + bj * HALF) = w; }
                asm volatile("" ::: "memory"); }
    }
};
struct EpiI8 {
    static constexpr bool PERM = true, AFTER_DRAIN = false;
    bf16_t* O; int ldc; const float* sa; const float* sb;
    __device__ __forceinline__ void operator()(const f32x4 (&acc)[2][2][4][2], const Unit& u, int wr, int wc, int fr, int fq) const {
        const int row0 = u.pm * BM + wr * 64 + fr, col0 = u.pn * BM + wc * 32 + 8 * fq;
        f32x4 sc[2][2];
#pragma unroll
        for (int bj = 0; bj < 2; ++bj)
#pragma unroll
            for (int n = 0; n < 2; ++n) sc[bj][n] = *(const f32x4*)(sb + col0 + bj * HALF + 4 * n);
#pragma unroll
        for (int ai = 0; ai < 2; ++ai)
#pragma unroll
            for (int m = 0; m < 4; ++m) { const int row = row0 + ai * HALF + m * 16; const float sr = sa[row]; bf16_t* rowp = O + (size_t)row * ldc + col0;
#pragma unroll
                for (int bj = 0; bj < 2; ++bj) { const i32x4 i0 = __builtin_bit_cast(i32x4, acc[ai][bj][m][0]), i1 = __builtin_bit_cast(i32x4, acc[ai][bj][m][1]);
                    const f32x4 v0 = __builtin_convertvector(i0, f32x4) * sc[bj][0] * sr, v1 = __builtin_convertvector(i1, f32x4) * sc[bj][1] * sr;
                    u32x4 w; w.x = cvt_pk_bf16(v0[0], v0[1]); w.y = cvt_pk_bf16(v0[2], v0[3]); w.z = cvt_pk_bf16(v1[0], v1[1]); w.w = cvt_pk_bf16(v1[2], v1[3]);
                    *(u32x4*)(rowp + bj * HALF) = w; } }
    }
};
template <class Epi, class Sched, bool ALIGN_EPI = false, bool SP2 = false, int MODE = 0>
__device__ __forceinline__ void gemm_phase(PG8_LAS unsigned char* lds, const Gemm g, const Sched& S, const Epi& E) {
    const int tid = threadIdx.x, wid = __builtin_amdgcn_readfirstlane(tid >> 6), lane = tid & 63, wr = wid >> 2, wc = wid & 3, fr = lane & 15, fq = lane >> 4;
    constexpr bool F8 = MODE == 1, I8 = MODE == 2; constexpr int ES = MODE ? 1 : 2; const int K = g.K, nt = K * ES / (BK * 2);
    unsigned voffA[2], voffB[2];
#pragma unroll
    for (int i = 0; i < 2; ++i) { int R, C; stage_rc(tid * 16 + i * 8192, R, C); const int Rb = Epi::PERM ? ((R & ~31) + perm32(R & 31)) : R;
        voffA[i] = (unsigned)(R * g.lda * ES + C * 2); voffB[i] = (unsigned)(Rb * g.ldb * ES + C * 2); }
    const size_t kstep = (size_t)(BK * 2);
    const size_t hstepA = (size_t)HALF * g.lda * ES, hstepB = (size_t)HALF * g.ldb * ES;
    const size_t tstepA = 2 * hstepA, tstepB = 2 * hstepB;
    const unsigned ldsw = (unsigned)wid * 1024u;
    const int aoff = lds_byte(wr * 64 + fr, fq * 8), boff = lds_byte(wc * 32 + fr, fq * 8);
#define PG8_SA(b, h) (((b) * 2 + (h)) * HTB)
#define PG8_SB(b, h) ((4 + (b) * 2 + (h)) * HTB)
#define PG8_STAGE(bufoff, gbase, voff) do { _Pragma("unroll") for (int _i = 0; _i < 2; ++_i) \
        __builtin_amdgcn_global_load_lds((const unsigned*)((const char*)(gbase) + (voff)[_i]), (PG8_LAS unsigned*)(lds + (bufoff) + ldsw + _i * 8192), 16, 0, 0); } while (0)
#define PG8_LDA(dst, b, h) do { _Pragma("unroll") for (int m = 0; m < 4; ++m) { if constexpr (F8) dst##8[m] = PG8_CAT(*(const PG8_LAS bf16x8*)(lds + PG8_SA(b, h) + aoff + m * 2048), *(const PG8_LAS bf16x8*)(lds + PG8_SA(b, h) + aoff + m * 2048 + 1024)); \
        else { _Pragma("unroll") for (int k = 0; k < 2; ++k) dst[m][k] = *(const PG8_LAS bf16x8*)(lds + PG8_SA(b, h) + aoff + m * 2048 + k * 1024); } } } while (0)
#define PG8_LDB(dst, b, h) do { _Pragma("unroll") for (int n = 0; n < 2; ++n) { if constexpr (F8) dst##8[n] = PG8_CAT(*(const PG8_LAS bf16x8*)(lds + PG8_SB(b, h) + boff + n * 2048), *(const PG8_LAS bf16x8*)(lds + PG8_SB(b, h) + boff + n * 2048 + 1024)); \
        else { _Pragma("unroll") for (int k = 0; k < 2; ++k) dst[n][k] = *(const PG8_LAS bf16x8*)(lds + PG8_SB(b, h) + boff + n * 2048 + k * 1024); } } } while (0)
#define PG8_MMA(ai, bj, At, Bt) do { __builtin_amdgcn_s_setprio(1); _Pragma("unroll") for (int m = 0; m < 4; ++m) _Pragma("unroll") for (int n = 0; n < 2; ++n) { \
        if constexpr (F8) asm volatile("v_mfma_scale_f32_16x16x128_f8f6f4 %0, %1, %2, %0, %3, %3 op_sel_hi:[0,0,0]" : "+v"(acc[ai][bj][m][n]) : "v"(Bt##8[n]), "v"(At##8[m]), "v"(sc1)); \
        else if constexpr (I8) { _Pragma("unroll") for (int k = 0; k < 2; ++k) acc[ai][bj][m][n] = __builtin_bit_cast(f32x4, __builtin_amdgcn_mfma_i32_16x16x64_i8(__builtin_bit_cast(i32x4, Bt[n][k]), __builtin_bit_cast(i32x4, At[m][k]), __builtin_bit_cast(i32x4, acc[ai][bj][m][n]), 0, 0, 0)); } \
        else { _Pragma("unroll") for (int k = 0; k < 2; ++k) acc[ai][bj][m][n] = __builtin_amdgcn_mfma_f32_16x16x32_bf16(Bt[n][k], At[m][k], acc[ai][bj][m][n], 0, 0, 0); } } \
        __builtin_amdgcn_s_setprio(0); } while (0)
#define PG8_CAT(lo, hi) __builtin_shufflevector(__builtin_bit_cast(i32x4, lo), __builtin_bit_cast(i32x4, hi), 0, 1, 2, 3, 4, 5, 6, 7)
#define PG8_WAIT_V(n) asm volatile("s_waitcnt vmcnt(" #n ")" ::: "memory")
#define PG8_WAIT_L(n) asm volatile("s_waitcnt lgkmcnt(" #n ")" ::: "memory")
#define PG8_BAR __builtin_amdgcn_s_barrier()
#define PG8_SCHED __builtin_amdgcn_sched_barrier(0)
    Unit cur, nxt; int ui = 0;
    if (!S.next(0, cur)) return;
    f32x4 acc[2][2][4][2];
#pragma unroll
    for (int a = 0; a < 2; ++a)
#pragma unroll
        for (int b = 0; b < 2; ++b)
#pragma unroll
            for (int m = 0; m < 4; ++m)
#pragma unroll
                for (int n = 0; n < 2; ++n) acc[a][b][m][n] = (f32x4){0.f, 0.f, 0.f, 0.f};
    int sc1 = 0x7F7F7F7F; asm volatile("" : "+v"(sc1));
    bf16x8 At[4][2], B0[2][2], B1[2][2]; i32x8 At8[4], B08[2], B18[2];
    const char* cA = (const char*)g.A + (size_t)cur.pm * tstepA + (g.agrp ? (size_t)(cur.pn / g.agrp) * K * ES : (size_t)0); const char* cB = (const char*)g.Bt + (size_t)cur.pn * tstepB + (g.bgrp ? (size_t)(cur.pm / g.bgrp) * K * ES : (size_t)0);
    S.a_ready(cur);
    if constexpr (SP2) {
        PG8_STAGE(PG8_SB(0, 0), cB, voffB); PG8_STAGE(PG8_SB(0, 1), cB + hstepB, voffB); PG8_STAGE(PG8_SA(0, 0), cA, voffA); PG8_STAGE(PG8_SA(0, 1), cA + hstepA, voffA);
        if (wr == 1) PG8_BAR;
        PG8_WAIT_V(2); PG8_BAR;
        PG8_STAGE(PG8_SB(1, 0), cB + kstep, voffB); PG8_STAGE(PG8_SA(1, 0), cA + kstep, voffA); PG8_STAGE(PG8_SB(1, 1), cB + hstepB + kstep, voffB);
        PG8_WAIT_V(6); PG8_BAR;
    } else {
        PG8_STAGE(PG8_SB(0, 0), cB, voffB); PG8_STAGE(PG8_SA(0, 0), cA, voffA); PG8_STAGE(PG8_SB(0, 1), cB + hstepB, voffB); PG8_STAGE(PG8_SA(0, 1), cA + hstepA, voffA);
        if (wr == 1) PG8_BAR;
        PG8_WAIT_V(4); PG8_BAR;
        PG8_STAGE(PG8_SB(1, 0), cB + kstep, voffB); PG8_STAGE(PG8_SA(1, 0), cA + kstep, voffA); PG8_STAGE(PG8_SB(1, 1), cB + hstepB + kstep, voffB);
        PG8_WAIT_V(6); PG8_BAR;
    }
    for (;;) {
        const bool has_next = S.next(ui + 1, nxt);
        const char* nA = has_next ? (const char*)g.A + (size_t)nxt.pm * tstepA + (g.agrp ? (size_t)(nxt.pn / g.agrp) * K * ES : (size_t)0) : cA; const char* nB = has_next ? (const char*)g.Bt + (size_t)nxt.pn * tstepB + (g.bgrp ? (size_t)(nxt.pm / g.bgrp) * K * ES : (size_t)0) : cB;
        for (int t = 0; t < nt; t += 2) {
            const bool last = (t == nt - 2);
            const char* a1 = cA + (size_t)(t + 1) * kstep;
            const char* a2 = last ? nA : cA + (size_t)(t + 2) * kstep; const char* b2 = last ? nB : cB + (size_t)(t + 2) * kstep;
            const char* a3 = a2 + kstep; const char* b3 = b2 + kstep;
            if (last && has_next) S.a_ready(nxt);
            if constexpr (SP2) {
            PG8_LDB(B0, 0, 0); PG8_LDB(B1, 0, 1); PG8_SCHED; PG8_LDA(At, 0, 0); PG8_STAGE(PG8_SA(1, 1), a1 + hstepA, voffA);
            PG8_WAIT_V(8); PG8_WAIT_L(0); PG8_BAR; PG8_MMA(0, 0, At, B0); PG8_MMA(0, 1, At, B1); PG8_BAR; PG8_SCHED;
            PG8_LDA(At, 0, 1); PG8_STAGE(PG8_SB(0, 0), b2, voffB); PG8_STAGE(PG8_SB(0, 1), b2 + hstepB, voffB); PG8_STAGE(PG8_SA(0, 0), a2, voffA);
            PG8_WAIT_V(8); PG8_WAIT_L(0); PG8_BAR; PG8_MMA(1, 0, At, B0); PG8_MMA(1, 1, At, B1); PG8_BAR; PG8_SCHED;
            PG8_LDB(B0, 1, 0); PG8_LDB(B1, 1, 1); PG8_SCHED; PG8_LDA(At, 1, 0); PG8_STAGE(PG8_SA(0, 1), a2 + hstepA, voffA);
            PG8_WAIT_V(8); PG8_WAIT_L(0); PG8_BAR; PG8_MMA(0, 0, At, B0); PG8_MMA(0, 1, At, B1); PG8_BAR; PG8_SCHED;
            PG8_LDA(At, 1, 1); PG8_STAGE(PG8_SB(1, 0), b3, voffB); PG8_STAGE(PG8_SB(1, 1), b3 + hstepB, voffB); PG8_STAGE(PG8_SA(1, 0), a3, voffA);
            PG8_WAIT_V(8); PG8_WAIT_L(0); PG8_BAR; PG8_MMA(1, 0, At, B0); PG8_MMA(1, 1, At, B1); PG8_BAR; PG8_SCHED;
            } else {
            PG8_LDB(B0, 0, 0); PG8_SCHED; PG8_LDA(At, 0, 0); PG8_STAGE(PG8_SA(1, 1), a1 + hstepA, voffA);
            PG8_WAIT_L(8); PG8_BAR; PG8_WAIT_L(0); PG8_MMA(0, 0, At, B0); PG8_BAR; PG8_SCHED;
            PG8_LDB(B1, 0, 1); PG8_STAGE(PG8_SB(0, 0), b2, voffB);
            PG8_BAR; PG8_WAIT_L(0); PG8_MMA(0, 1, At, B1); PG8_BAR;
            PG8_LDA(At, 0, 1); PG8_STAGE(PG8_SA(0, 0), a2, voffA);
            PG8_BAR; PG8_WAIT_L(0); PG8_MMA(1, 0, At, B0); PG8_BAR; PG8_SCHED;
            PG8_STAGE(PG8_SB(0, 1), b2 + hstepB, voffB);
            PG8_WAIT_V(6); PG8_BAR; PG8_MMA(1, 1, At, B1); PG8_BAR;
            PG8_LDB(B0, 1, 0); PG8_SCHED; PG8_LDA(At, 1, 0); PG8_STAGE(PG8_SA(0, 1), a2 + hstepA, voffA);
            PG8_WAIT_L(8); PG8_BAR; PG8_WAIT_L(0); PG8_MMA(0, 0, At, B0); PG8_BAR; PG8_SCHED;
            PG8_LDB(B1, 1, 1); PG8_STAGE(PG8_SB(1, 0), b3, voffB);
            PG8_BAR; PG8_WAIT_L(0); PG8_MMA(0, 1, At, B1); PG8_BAR;
            PG8_LDA(At, 1, 1); PG8_STAGE(PG8_SA(1, 0), a3, voffA);
            PG8_BAR; PG8_WAIT_L(0); PG8_MMA(1, 0, At, B0); PG8_BAR; PG8_SCHED;
            PG8_STAGE(PG8_SB(1, 1), b3 + hstepB, voffB);
            PG8_WAIT_V(6); PG8_BAR; PG8_MMA(1, 1, At, B1); PG8_BAR;
            }
        }
        if constexpr (ALIGN_EPI) { if (wr == 0) PG8_BAR; }
        if constexpr (F8) asm volatile("s_nop 15\n\ts_nop 15" ::: "memory");
        if constexpr (!Epi::AFTER_DRAIN) { E(acc, cur, wr, wc, fr, fq); S.done(cur); }
        if (!has_next) break;
#pragma unroll
        for (int a = 0; a < 2; ++a)
#pragma unroll
            for (int b = 0; b < 2; ++b)
#pragma unroll
                for (int m = 0; m < 4; ++m)
#pragma unroll
                    for (int n = 0; n < 2; ++n) acc[a][b][m][n] = (f32x4){0.f, 0.f, 0.f, 0.f};
        cur = nxt; cA = nA; cB = nB; ++ui;
        if constexpr (ALIGN_EPI) { if (wr == 1) PG8_BAR; }
    }
    PG8_WAIT_V(0);
    if constexpr (!ALIGN_EPI) { if (wr == 0) PG8_BAR; }
    PG8_BAR;
    if constexpr (Epi::AFTER_DRAIN) { E.fused(acc, cur, wr, wc, fr, fq, lds, wid, lane); S.done(cur); }
#undef PG8_SA
#undef PG8_SB
#undef PG8_STAGE
#undef PG8_LDA
#undef PG8_LDB
#undef PG8_MMA
#undef PG8_CAT
#undef PG8_WAIT_V
#undef PG8_WAIT_L
#undef PG8_BAR
#undef PG8_SCHED
}
}

namespace att {
typedef unsigned short bf16;
using bf16x8 = __attribute__((ext_vector_type(8))) short;
using s16x4  = __attribute__((ext_vector_type(4))) short;
using f32x16 = __attribute__((ext_vector_type(16))) float;
using u32x4  = __attribute__((ext_vector_type(4))) unsigned;
constexpr int HD_ = 128, NW = 8, QBLK = 32, KVBLK = 64, LDQ = 128  , LDO = 4096 + 128;
constexpr float SCALE = 0.088388347648318440f, INV_SCALE = 11.313708498984761f, THR = 8.f, NEG = -1e30f;
constexpr size_t SHM_V = KVBLK * HD_ * 2, SHM_K = KVBLK * HD_ * 2, OFF_WS = 2 * SHM_V + 2 * SHM_K, OFF_RPB = OFF_WS + NW * 64 * 4, OFF_STG = OFF_RPB + 3072, OFF_SINK = OFF_STG + NW * 32 * 272, SHM_ATTN = OFF_SINK + 64;
constexpr int STG_ROW = 272, STG_WAVE = 32 * STG_ROW;
#define KSWZ(row, colB) ((row) * 256 + ((colB) ^ (((row) & 7) << 4)))
#define SBAR() __builtin_amdgcn_sched_barrier(0)
__device__ __forceinline__ int crow(int r, int hi) { return (r & 3) + 8 * (r >> 2) + 4 * hi; }
__device__ __forceinline__ unsigned cvtpk(float lo, float hi) { unsigned r; asm volatile("v_cvt_pk_bf16_f32 %0, %1, %2" : "=v"(r) : "v"(lo), "v"(hi)); return r; }

struct Unit {
    const bf16* q;
    const bf16* kc; const bf16* vc; int nctx;
    const bf16* kl; const bf16* vl;
    int nt;
    int mask;
    int qpos0, kpos0;
    int has_sink, sink_i;
    const float* rpb;
    const bf16* gate; unsigned char* out;
};

__device__ __forceinline__ void partialSM(f32x16& p0, f32x16& p1, float& m_reg, float& mn, float& alpha) {
    constexpr float C = SCALE * 1.4426950408889634f;
    float pmax = p0[0];
#pragma unroll
    for (int r = 1; r < 16; ++r) pmax = fmaxf(pmax, p0[r]);
#pragma unroll
    for (int r = 0; r < 16; ++r) pmax = fmaxf(pmax, p1[r]);
    { auto rr = __builtin_amdgcn_permlane32_swap(__float_as_uint(pmax), __float_as_uint(pmax), false, false);
      pmax = fmaxf(__uint_as_float(rr[0]), __uint_as_float(rr[1])); }
    if (__builtin_expect(__all(pmax - m_reg <= THR / SCALE), 1)) { mn = m_reg; alpha = 1.f; }
    else { mn = fmaxf(m_reg, pmax); alpha = __builtin_amdgcn_exp2f((m_reg - mn) * C); m_reg = mn; }
    const float mnC = -mn * C;
#pragma unroll
    for (int r = 0; r < 16; ++r) p0[r] = fmaf(p0[r], C, mnC);
#pragma unroll
    for (int r = 0; r < 16; ++r) p1[r] = fmaf(p1[r], C, mnC);
#pragma unroll
    for (int r = 0; r < 16; ++r) p0[r] = __builtin_amdgcn_exp2f(p0[r]);
}
__device__ __forceinline__ void finishSM(f32x16& p0, f32x16& p1, float alpha, float& l_reg, bf16x8& pa0, bf16x8& pa1, bf16x8& pa2, bf16x8& pa3) {
#pragma unroll
    for (int r = 0; r < 16; ++r) p1[r] = __builtin_amdgcn_exp2f(p1[r]);
    float ps = 0;
#pragma unroll
    for (int r = 0; r < 16; ++r) ps += p0[r];
#pragma unroll
    for (int r = 0; r < 16; ++r) ps += p1[r];
    { auto rr = __builtin_amdgcn_permlane32_swap(__float_as_uint(ps), __float_as_uint(ps), false, false);
      ps = __uint_as_float(rr[0]) + __uint_as_float(rr[1]); }
    l_reg = l_reg * alpha + ps;
#define ATT_PK4(P, BASE, OUT) do { unsigned a0 = cvtpk(P[BASE + 0], P[BASE + 1]), a1 = cvtpk(P[BASE + 2], P[BASE + 3]);   \
    unsigned b0 = cvtpk(P[BASE + 4], P[BASE + 5]), b1 = cvtpk(P[BASE + 6], P[BASE + 7]);                              \
    auto r0 = __builtin_amdgcn_permlane32_swap(a0, b0, false, false); auto r1 = __builtin_amdgcn_permlane32_swap(a1, b1, false, false); \
    u32x4 w = {r0[0], r1[0], r0[1], r1[1]}; OUT = *reinterpret_cast<bf16x8*>(&w); } while (0)
    ATT_PK4(p0, 0, pa0); ATT_PK4(p0, 8, pa1); ATT_PK4(p1, 0, pa2); ATT_PK4(p1, 8, pa3);
#undef ATT_PK4
}
__device__ __forceinline__ void qkt(f32x16& p0, f32x16& p1, const char* Ks, const bf16x8* qr, int r32, int hi) {
    p0 = f32x16{}; p1 = f32x16{};
#pragma unroll
    for (int d0 = 0; d0 < 8; ++d0) { const int cb = (d0 * 16 + hi * 8) * 2;
        const bf16x8 b0 = *reinterpret_cast<const bf16x8*>(Ks + KSWZ(r32, cb));
        const bf16x8 b1 = *reinterpret_cast<const bf16x8*>(Ks + KSWZ(32 + r32, cb));
        p0 = __builtin_amdgcn_mfma_f32_32x32x16_bf16(b0, qr[d0], p0, 0, 0, 0);
        p1 = __builtin_amdgcn_mfma_f32_32x32x16_bf16(b1, qr[d0], p1, 0, 0, 0); }
}
__device__ __forceinline__ int v_st(int k, int c) { const int kk = (k & ~0xC) | ((k & 4) << 1) | ((k & 8) >> 1); return ((kk >> 3) * 4 + (c >> 5)) * 512 + ((kk & 7) * 32 + (c & 31)) * 2; }
__device__ __forceinline__ int v_rd_base(int lane) { return ((lane & 3) << 3) | (((lane >> 2) & 3) << 6) | (((lane >> 4) & 1) << 5) | (((lane >> 5) & 1) << 8); }
constexpr int v_rd_off(int d0, int ks, int half) { return d0 * 512 + ks * 4096 + half * 2048; }
template <int OFF> __device__ __forceinline__ s16x4 tr_read(int vb) {
    s16x4 r; asm volatile("ds_read_b64_tr_b16 %0, %1 offset:%2" : "=&v"(r) : "v"(vb), "i"(OFF) : "memory"); return r;
}
template <int D0> __device__ __forceinline__ void pv_one(f32x16& od, int vb, bf16x8 pa0, bf16x8 pa1, bf16x8 pa2, bf16x8 pa3) {
    const s16x4 l0 = tr_read<v_rd_off(D0, 0, 0)>(vb), h0 = tr_read<v_rd_off(D0, 0, 1)>(vb), l1 = tr_read<v_rd_off(D0, 1, 0)>(vb), h1 = tr_read<v_rd_off(D0, 1, 1)>(vb);
    const s16x4 l2 = tr_read<v_rd_off(D0, 2, 0)>(vb), h2 = tr_read<v_rd_off(D0, 2, 1)>(vb), l3 = tr_read<v_rd_off(D0, 3, 0)>(vb), h3 = tr_read<v_rd_off(D0, 3, 1)>(vb);
    asm volatile("s_waitcnt lgkmcnt(0)" ::: "memory"); SBAR();
#define ATT_PK(L, H) (bf16x8){L[0], L[1], L[2], L[3], H[0], H[1], H[2], H[3]}
    od = __builtin_amdgcn_mfma_f32_32x32x16_bf16(pa0, ATT_PK(l0, h0), od, 0, 0, 0);
    od = __builtin_amdgcn_mfma_f32_32x32x16_bf16(pa1, ATT_PK(l1, h1), od, 0, 0, 0);
    od = __builtin_amdgcn_mfma_f32_32x32x16_bf16(pa2, ATT_PK(l2, h2), od, 0, 0, 0);
    od = __builtin_amdgcn_mfma_f32_32x32x16_bf16(pa3, ATT_PK(l3, h3), od, 0, 0, 0);
#undef ATT_PK
}
__device__ __forceinline__ void pv_d0(f32x16* o, int vb, bf16x8 pa0, bf16x8 pa1, bf16x8 pa2, bf16x8 pa3) {
    pv_one<0>(o[0], vb, pa0, pa1, pa2, pa3); pv_one<1>(o[1], vb, pa0, pa1, pa2, pa3); pv_one<2>(o[2], vb, pa0, pa1, pa2, pa3); pv_one<3>(o[3], vb, pa0, pa1, pa2, pa3);
}
__device__ __forceinline__ void apply_mask(f32x16& p0, f32x16& p1, const Unit& u, int j, int wid, int r32, int hi, const float* rpb_l) {
    if (u.mask == 0 || j < u.nctx) return;
    const int jl = j - u.nctx;
    asm volatile("" : "+v"(r32), "+v"(hi));
    if (u.mask == 1) {
        const int qw0 = u.qpos0 + wid * QBLK, k0 = u.kpos0 + jl * KVBLK;
        if (qw0 + 31 - k0 <= 128 && k0 + 63 - qw0 <= 128) return;
        if (qw0 - (k0 + 63) > 128 || k0 - (qw0 + 31) > 128) {
#pragma unroll
            for (int r = 0; r < 16; ++r) { p0[r] = NEG; p1[r] = NEG; }
            return; }
        const int dl = qw0 + r32 - k0 - 4 * hi + 128;
#pragma unroll
        for (int r = 0; r < 16; ++r) { const int kc0 = (r & 3) + 8 * (r >> 2);
            p0[r] = (unsigned)(dl - kc0) > 256u ? NEG : p0[r]; p1[r] = (unsigned)(dl - kc0 - 32) > 256u ? NEG : p1[r]; }
    } else {
        const int rq = u.qpos0 + (wid >> 1), kr = u.kpos0 + jl;
        const int rs = rq - 4 < 0 ? 0 : (rq - 4 > 8 ? 8 : rq - 4);
        if (kr < rs || kr >= rs + 8) {
#pragma unroll
            for (int r = 0; r < 16; ++r) { p0[r] = NEG; p1[r] = NEG; }
            return; }
        const int c = (wid & 1) * 32 + r32, cs = c - 8 < 0 ? 0 : (c - 8 > 48 ? 48 : c - 8);
        const int lv = 4 * hi - cs;
        const float* tb = rpb_l + (kr - rq + 7) * 31 + (4 * hi - c + 15);
#pragma unroll
        for (int rg = 0; rg < 16; rg += 4) {
            float b0[4], b1[4];
#pragma unroll
            for (int e = 0; e < 4; ++e) { const int kc0 = ((rg + e) & 3) + 8 * ((rg + e) >> 2); b0[e] = tb[kc0]; b1[e] = tb[kc0 + 32]; }
#pragma unroll
            for (int e = 0; e < 4; ++e) { const int r = rg + e, kc0 = (r & 3) + 8 * (r >> 2);
                p0[r] = (unsigned)(kc0 + lv) < 16u ? p0[r] + b0[e] : NEG; p1[r] = (unsigned)(kc0 + 32 + lv) < 16u ? p1[r] + b1[e] : NEG; }
        }
    }
}

struct Regs { bf16x8 qr[8]; bf16x8 vs0[2], vs1[2], ks0[2], ks1[2]; float rpbv; u32x4 w[4]; unsigned char* wp; };
__device__ __forceinline__ void attn_flush(Regs& R) {
#pragma unroll
    for (int i = 0; i < 4; ++i) *reinterpret_cast<u32x4*>(R.wp + (size_t)i * 8 * LDO) = R.w[i];
}
template <int I> __device__ __forceinline__ void sload(const Unit& u, Regs& R, int j, int sr, int sc) {
    const bf16* kt_; const bf16* vt_; constexpr int ld_ = LDQ;
    if (j < u.nctx) { kt_ = u.kc + (size_t)j * KVBLK * LDQ; vt_ = u.vc + (size_t)j * KVBLK * LDQ; }
    else { kt_ = u.kl + (size_t)(j - u.nctx) * KVBLK * LDQ; vt_ = u.vl + (size_t)(j - u.nctx) * KVBLK * LDQ; }
    R.vs0[I] = *reinterpret_cast<const bf16x8*>(vt_ + (size_t)sr * ld_ + sc); R.vs1[I] = *reinterpret_cast<const bf16x8*>(vt_ + (size_t)(32 + sr) * ld_ + sc);
    R.ks0[I] = *reinterpret_cast<const bf16x8*>(kt_ + (size_t)sr * ld_ + sc); R.ks1[I] = *reinterpret_cast<const bf16x8*>(kt_ + (size_t)(32 + sr) * ld_ + sc);
}
__device__ __forceinline__ void attn_prefetch(const Unit& u, Regs& R) {
    int tid = threadIdx.x; asm volatile("" : "+v"(tid));
    const int wid = __builtin_amdgcn_readfirstlane(tid >> 6), lane = tid & 63, r32 = lane & 31, hi = lane >> 5, sr = tid >> 4, sc = (tid & 15) * 8;
    const bf16* Qw = u.q + (size_t)(wid * QBLK + r32) * LDQ + hi * 8;
#pragma unroll
    for (int d0 = 0; d0 < 8; ++d0) R.qr[d0] = *reinterpret_cast<const bf16x8*>(Qw + d0 * 16);
    sload<0>(u, R, 0, sr, sc); sload<1>(u, R, 1, sr, sc);
    R.rpbv = u.rpb[tid < 15 * 31 ? tid : 0];
}
__device__ __forceinline__ void attn_unit(const Unit& u, bool has_next, const Unit& nu, Regs& R, char* lds, bool has_prev) {
    int tid = threadIdx.x; asm volatile("" : "+v"(tid));
    const int wid = __builtin_amdgcn_readfirstlane(tid >> 6), lane = tid & 63, r32 = lane & 31, hi = lane >> 5;
    char* V_lds = lds; char* K_lds = lds + 2 * SHM_V;
    float* ws = (float*)(lds + OFF_WS) + wid * 64; float* li_l = ws; float* al_l = ws + 32;
    float* rpb_l = (float*)(lds + OFF_RPB + 256);
    if (u.mask == 2) { if (tid < 15 * 31) rpb_l[tid] = R.rpbv * INV_SCALE; }
    float m_reg = NEG, l_reg = 0; f32x16 o[4] = {};
    const int sr = tid >> 4, sc = (tid & 15) * 8, vst0 = v_st(sr, sc), vst1 = v_st(32 + sr, sc);
    const int vb0 = (int)(uintptr_t)V_lds + v_rd_base(lane);
#define ATT_SLOAD(i, j) sload<i>(u, R, (j), sr, sc)
#define ATT_SWRITE(b, i) do { *(bf16x8*)(V_lds + (b) * SHM_V + vst0) = R.vs0[i]; *(bf16x8*)(V_lds + (b) * SHM_V + vst1) = R.vs1[i]; const int kc_ = sc * 2;  \
    *(bf16x8*)(K_lds + (b) * SHM_K + KSWZ(sr, kc_)) = R.ks0[i]; *(bf16x8*)(K_lds + (b) * SHM_K + KSWZ(32 + sr, kc_)) = R.ks1[i]; } while (0)
#define ATT_SWAIT() asm volatile("s_waitcnt vmcnt(4)" ::: "memory")
#define ATT_RESC(a) do { if (__any((a) < 1.f)) { if (hi == 0) al_l[r32] = (a); asm volatile("s_waitcnt lgkmcnt(0)" ::: "memory"); \
    _Pragma("unroll") for (int d = 0; d < 4; ++d) _Pragma("unroll") for (int r = 0; r < 16; ++r) o[d][r] *= al_l[crow(r, hi)]; } } while (0)
    f32x16 pA0, pA1, pB0, pB1; float mnA, mnB, alA, alB; bf16x8 pa0, pa1, pa2, pa3; const int NT = u.nt;
    constexpr int SE = 0, SO = 1;
    ATT_SWRITE(0, SE);
    {
        const unsigned gl = (unsigned)(uintptr_t)(lds + OFF_STG) + (unsigned)wid * (unsigned)STG_WAVE;
#pragma unroll
        for (int t = 0; t < 8; ++t) { const int rr = 4 * t + (lane >> 4), c = (lane & 15) ^ (rr & 15); const unsigned voff = (unsigned)(((wid * QBLK + rr) * LDQ + c * 8) * 2);
            asm volatile("s_mov_b32 m0, %0\n\ts_nop 0\n\tglobal_load_lds_dwordx4 %1, %2" :: "s"(gl + t * 1024), "v"(voff), "s"(u.gate) : "memory"); }
    }
    ATT_SLOAD(SE, 2);
    if (has_prev) attn_flush(R);
    __syncthreads();
    qkt(pA0, pA1, K_lds, R.qr, r32, hi); apply_mask(pA0, pA1, u, 0, wid, r32, hi, rpb_l); partialSM(pA0, pA1, m_reg, mnA, alA);
    ATT_SWRITE(1, SO); __syncthreads();
    for (int j = 1; j + 1 < NT; j += 2) {
        SBAR(); qkt(pB0, pB1, K_lds + SHM_K, R.qr, r32, hi);
        finishSM(pA0, pA1, alA, l_reg, pa0, pa1, pa2, pa3); SBAR();
        ATT_SLOAD(SO, j + 2); SBAR();
        pv_d0(o, vb0, pa0, pa1, pa2, pa3); apply_mask(pB0, pB1, u, j, wid, r32, hi, rpb_l); partialSM(pB0, pB1, m_reg, mnB, alB);
        __syncthreads(); ATT_SWAIT(); ATT_SWRITE(0, SE);
        ATT_RESC(alB); __syncthreads();
        SBAR(); qkt(pA0, pA1, K_lds, R.qr, r32, hi);
        finishSM(pB0, pB1, alB, l_reg, pa0, pa1, pa2, pa3); SBAR();
        ATT_SLOAD(SE, j + 3 < NT ? j + 3 : NT - 1); SBAR();
        pv_d0(o, vb0 + (int)SHM_V, pa0, pa1, pa2, pa3); apply_mask(pA0, pA1, u, j + 1, wid, r32, hi, rpb_l); partialSM(pA0, pA1, m_reg, mnA, alA);
        __syncthreads(); ATT_SWAIT(); ATT_SWRITE(1, SO);
        ATT_RESC(alA); __syncthreads();
    }
    SBAR(); qkt(pB0, pB1, K_lds + SHM_K, R.qr, r32, hi);
    finishSM(pA0, pA1, alA, l_reg, pa0, pa1, pa2, pa3); SBAR();
    if (has_next) attn_prefetch(nu, R);
    SBAR();
    pv_d0(o, vb0, pa0, pa1, pa2, pa3); apply_mask(pB0, pB1, u, NT - 1, wid, r32, hi, rpb_l); partialSM(pB0, pB1, m_reg, mnB, alB);
    __syncthreads(); ATT_RESC(alB);
    finishSM(pB0, pB1, alB, l_reg, pa0, pa1, pa2, pa3); SBAR();
    u32x4 gA[4], gB[4];
    { const char* gs_ = lds + OFF_STG + wid * STG_WAVE;
#pragma unroll
      for (int i = 0; i < 4; ++i) { const int id = i * 64 + lane, row = id >> 3, ch = (id & 7) * 2;
          gA[i] = *reinterpret_cast<const u32x4*>(gs_ + row * 256 + ((ch ^ (row & 15)) << 4)); gB[i] = *reinterpret_cast<const u32x4*>(gs_ + row * 256 + (((ch + 1) ^ (row & 15)) << 4)); } }
    SBAR();
    pv_d0(o, vb0 + (int)SHM_V, pa0, pa1, pa2, pa3);
    if (u.has_sink) l_reg += __builtin_amdgcn_exp2f(((const float*)(lds + OFF_SINK))[u.sink_i] * 1.4426950408889634f - m_reg * (SCALE * 1.4426950408889634f));
    if (hi == 0) li_l[r32] = l_reg;
    asm volatile("s_waitcnt lgkmcnt(0)" ::: "memory");
    int hi_e = hi, r32_e = r32, lane_e = lane; asm volatile("" : "+v"(hi_e), "+v"(r32_e), "+v"(lane_e));
    char* stg = lds + OFF_STG + wid * STG_WAVE;
    typedef float f32x4e __attribute__((ext_vector_type(4)));
    f32x4e liv[4];
#pragma unroll
    for (int k4 = 0; k4 < 4; ++k4) liv[k4] = *reinterpret_cast<const f32x4e*>(li_l + 8 * k4 + 4 * hi_e);
#pragma unroll
    for (int r = 0; r < 16; ++r) { const int orow = crow(r, hi_e); const float rl = 8.0f * __builtin_amdgcn_rcpf(liv[r >> 2][r & 3]);
#pragma unroll
        for (int d0 = 0; d0 < 4; ++d0) *(bf16*)(stg + orow * STG_ROW + (d0 * 32 + r32_e) * 2) = (bf16)(cvtpk(o[d0][r] * rl, 0.f) & 0xffffu); }
    asm volatile("s_waitcnt lgkmcnt(0)" ::: "memory");
    unsigned char* ow = u.out + (size_t)(wid * QBLK) * LDO;
#pragma unroll
    for (int i = 0; i < 4; ++i) { const int id = i * 64 + lane_e, row = id >> 3, c16 = (id & 7) * 16;
        const u32x4 oA = *reinterpret_cast<const u32x4*>(stg + row * STG_ROW + c16 * 2), oB = *reinterpret_cast<const u32x4*>(stg + row * STG_ROW + c16 * 2 + 16);
        u32x4 w;
#pragma unroll
        for (int h2 = 0; h2 < 2; ++h2) { const u32x4 gv = h2 ? gB[i] : gA[i], ov = h2 ? oB : oA; float y[8];
            typedef float f32x2 __attribute__((ext_vector_type(2)));
#pragma unroll
            for (int e = 0; e < 4; ++e) { const f32x2 g = {__uint_as_float(gv[e] << 16), __uint_as_float(gv[e] & 0xffff0000u)}, o2 = {__uint_as_float(ov[e] << 16), __uint_as_float(ov[e] & 0xffff0000u)};
                const f32x2 t = g * -1.4426950408889634f; f32x2 d = {__builtin_amdgcn_exp2f(t.x), __builtin_amdgcn_exp2f(t.y)}; d = d + 1.0f;
                const f32x2 r = {__builtin_amdgcn_rcpf(d.x), __builtin_amdgcn_rcpf(d.y)}, yy = o2 * (g * r);
                y[2 * e] = yy.x; y[2 * e + 1] = yy.y; }
            int w0 = 0, w1 = 0;
            w0 = __builtin_amdgcn_cvt_pk_fp8_f32(y[0], y[1], w0, false); w0 = __builtin_amdgcn_cvt_pk_fp8_f32(y[2], y[3], w0, true);
            w1 = __builtin_amdgcn_cvt_pk_fp8_f32(y[4], y[5], w1, false); w1 = __builtin_amdgcn_cvt_pk_fp8_f32(y[6], y[7], w1, true);
            w[2 * h2] = (unsigned)w0; w[2 * h2 + 1] = (unsigned)w1; }
        R.w[i] = w; }
    R.wp = ow + (size_t)(lane_e >> 3) * LDO + (lane_e & 7) * 16;
#undef ATT_SLOAD
#undef ATT_SWRITE
#undef ATT_SWAIT
#undef ATT_RESC
}
#undef KSWZ
#undef SBAR
}

constexpr int D = 4096, NCTX = 8192, NLAT = 8192, M_TOK = NCTX + NLAT;
constexpr int CTX_B = 32, CTX_L = 256, LAT_B = 8, LAT_L = 1024, PAST = 512, GRID_W = 64;
constexpr int HD = 128, NIN = 13312, NPIN = 8192;
constexpr int LDA = D + 64, LDG = 1024 + 64, LD8 = D + 128;
constexpr int C_QA = 0, C_KA = 2048, C_VA = 2560, C_QB = 3072, C_KB = 5120, C_VB = 7168, C_GATE = 9216;
constexpr int NCOND = 9, NMOD = 3 * D;
constexpr int KSPLIT = 16;
constexpr float NORM_EPS = 1e-6f;
constexpr size_t OFF_Y = 0, OFF_NAK = (size_t)M_TOK * D, OFF_NAV = OFF_NAK + (size_t)NCTX * 512, OFF_NBK = OFF_NAV + (size_t)NCTX * 512, OFF_NBV = OFF_NBK + (size_t)NCTX * 2048, OUT_TOTAL = OFF_NBV + (size_t)NCTX * 2048;

constexpr size_t MiB = 1u << 20;
constexpr size_t WS_CTL = 0, CTL_ZERO_BYTES = 32768;
constexpr size_t WS_MODP = 1 * MiB;
constexpr size_t WS_MODF = 15 * MiB;
constexpr size_t WS_WIN = 16 * MiB;
constexpr size_t WS_WKV = 70 * MiB;
constexpr size_t WS_WOUT = 122 * MiB;
constexpr size_t WS_WPIN = 155 * MiB;
constexpr size_t WS_WGRP = 220 * MiB;
constexpr size_t WS_WPOUT = 229 * MiB;
constexpr size_t WS_CAK = 262 * MiB, WS_CAV = 266 * MiB, WS_CBK = 270 * MiB, WS_CBV = 286 * MiB;
constexpr size_t WS_H = 302 * MiB;
constexpr size_t WS_H16 = 370 * MiB;
constexpr size_t WS_QKVG = 436 * MiB;
constexpr size_t WS_ATT = 852 * MiB;
constexpr size_t WS_X1 = 982 * MiB;
constexpr size_t WS_X2 = 1110 * MiB;
constexpr size_t WS_WU = 1238 * MiB;
constexpr size_t WS_WQ = 1272 * MiB;
constexpr size_t WS_WQ2 = 1306 * MiB;
constexpr size_t WS_END = 1324 * MiB;
constexpr size_t WS_ROPE = 15 * MiB + 1015808;
constexpr size_t WS_SCL = 15 * MiB + 917504;
static_assert(WS_WIN + (size_t)NIN * LD8 <= WS_WKV && WS_WKV + (size_t)5120 * LDA * 2 <= WS_WOUT && WS_WOUT + (size_t)D * LD8 <= WS_WPIN && WS_WPIN + (size_t)NPIN * LDA * 2 <= WS_WGRP && WS_WGRP + (size_t)4096 * LDG * 2 <= WS_WPOUT && WS_WPOUT + (size_t)D * LDA * 2 <= WS_CAK, "weights map");
static_assert(WS_H + (size_t)M_TOK * LD8 <= WS_H16 && WS_H16 + (size_t)NCTX * LDA * 2 <= WS_QKVG && WS_H + (size_t)M_TOK * LDA * 2 <= WS_QKVG && WS_QKVG + (size_t)M_TOK * NIN * 2 <= WS_ATT && WS_ATT + (size_t)M_TOK * LDA * 2 <= WS_X1 && WS_X1 + (size_t)M_TOK * D * 2 <= WS_X2 && WS_X2 + (size_t)M_TOK * D * 2 <= WS_WU && WS_WU + (size_t)D * LDA * 2 <= WS_WQ && WS_WQ + (size_t)NPIN * LD8 <= WS_WQ2 && WS_WQ2 + (size_t)D * LD8 <= WS_END && WS_MODF + (size_t)2 * NCOND * NMOD * 4 <= WS_SCL && WS_SCL + (M_TOK + NPIN + D) * 4 <= 16 * MiB, "activation map");
constexpr int CW_TMO = 0, CW_CODE = 1, CW_BAR = 4096;

constexpr int NWAVES = 8, NTHREADS = NWAVES * 64;
constexpr int LDS_BYTES = 150528;
constexpr int RING_OFF = 0, RING_BYTES = LDS_BYTES - 512;
constexpr int ROPE_LDS_OFF = 131072;
constexpr int LDSCTL_OFF = RING_BYTES, MISC_OFF = LDSCTL_OFF + 320;
static_assert(8 * 16640 <= RING_BYTES && MISC_OFF + 128 <= LDS_BYTES && (int)att::SHM_ATTN <= RING_BYTES && ROPE_LDS_OFF + 2 * 64 * pg8::ROPE_LD * 4 <= RING_BYTES, "LDS map");

#define GAS __attribute__((address_space(1)))
#define LAS __attribute__((address_space(3)))
typedef unsigned short bf16;
typedef unsigned v4u __attribute__((ext_vector_type(4)));
typedef unsigned v2u __attribute__((ext_vector_type(2)));
typedef float f32x4 __attribute__((ext_vector_type(4)));
typedef GAS unsigned gu32;
#define RLX_AGENT __ATOMIC_RELAXED, __HIP_MEMORY_SCOPE_AGENT
#define LDS_WAIT() asm volatile("s_waitcnt lgkmcnt(0)" ::: "memory")
#define VM_WAIT() asm volatile("s_waitcnt vmcnt(0)" ::: "memory")
__device__ __forceinline__ unsigned f2bf(float f) { unsigned u = __builtin_bit_cast(unsigned, f); return (u + 0x7fffu + ((u >> 16) & 1u)) >> 16; }
__device__ __forceinline__ unsigned pk2(float lo, float hi) { unsigned r; asm("v_cvt_pk_bf16_f32 %0, %1, %2" : "=v"(r) : "v"(lo), "v"(hi)); return r; }
__device__ __forceinline__ float bflo(unsigned w) { return __uint_as_float(w << 16); }
__device__ __forceinline__ float bfhi(unsigned w) { return __uint_as_float(w & 0xffff0000u); }
__device__ __forceinline__ float silu(float x) { return x / (1.0f + __expf(-x)); }
constexpr size_t QBLK_STRIDE = (size_t)M_TOK * HD;
__device__ __forceinline__ size_t qoff(size_t row, int col) { return (size_t)(col >> 7) * QBLK_STRIDE + row * HD + (col & 127); }


constexpr float S8_W = 256.0f, S8_ATT = 8.0f, S8_H = 4.0f;
__device__ __forceinline__ unsigned pk4_i8(float a, float b, float c, float d) {
    unsigned r = 0;
    r = __builtin_amdgcn_cvt_pk_u8_f32(a + 128.0f, 0, r); r = __builtin_amdgcn_cvt_pk_u8_f32(b + 128.0f, 1, r); r = __builtin_amdgcn_cvt_pk_u8_f32(c + 128.0f, 2, r); r = __builtin_amdgcn_cvt_pk_u8_f32(d + 128.0f, 3, r);
    return r ^ 0x80808080u;
}
__device__ __forceinline__ unsigned pk4_fp8(float a, float b, float c, float d) {
    int r = 0; r = __builtin_amdgcn_cvt_pk_fp8_f32(a, b, r, false); r = __builtin_amdgcn_cvt_pk_fp8_f32(c, d, r, true); return (unsigned)r;
}

#define XB_TMO      128
#define XB_XCNT(j)  (256  + 64 * (j))
#define XB_XSUB(j)  (1280 + 64 * (j))
#define XB_XGEN(j)  (2304 + 64 * (j))
#define XB_TOP      3328
#define XB_TOPGEN   3392
#define XCD_BAR_WORDS 3456
#define XB_SPIN_CAP (1u << 18)

__device__ __forceinline__ unsigned xb_ld(unsigned* p)              { return __hip_atomic_load(p, __ATOMIC_RELAXED, __HIP_MEMORY_SCOPE_AGENT); }
__device__ __forceinline__ unsigned xb_add(unsigned* p, unsigned v) { return __hip_atomic_fetch_add(p, v, __ATOMIC_RELAXED, __HIP_MEMORY_SCOPE_AGENT); }
__device__ __forceinline__ unsigned xb_xcc_id() { return (unsigned)__builtin_amdgcn_s_getreg((3 << 11) | 20) & 0xFu; }
#define XB_SPIN(cond, bar) do { unsigned _sp = 0; while (cond) { __builtin_amdgcn_s_sleep(1); \
    if ((++_sp & 255u) == 0u) { if (xb_ld(&(bar)[XB_TMO])) break; if (_sp > XB_SPIN_CAP) { atomicAdd(&(bar)[XB_TMO], 1u); break; } } } } while (0)

struct XcdBarrier {
    unsigned* bar; unsigned x;
    volatile LAS unsigned* st;
};

__device__ __forceinline__ XcdBarrier xcd_barrier_post(unsigned* bar, volatile LAS unsigned* st) {
    XcdBarrier b; b.bar = bar; b.x = xb_xcc_id(); b.st = st;
    if (threadIdx.x == 0) (void)xb_add(&bar[XB_XCNT(b.x)], 1u);
    return b;
}
__device__ __forceinline__ void xcd_barrier_complete(unsigned* bar, unsigned x, unsigned& nloc, unsigned& nx) {
    const unsigned G = gridDim.x * gridDim.y * gridDim.z;
    unsigned sum, cnt, mine, sp = 0u;
    for (;;) {
        sum = 0u; cnt = 0u; mine = 0u;
#pragma unroll
        for (unsigned j = 0; j < 16; ++j) { const unsigned c = xb_ld(&bar[XB_XCNT(j)]); sum += c; cnt += (c > 0u) ? 1u : 0u; mine = (j == x) ? c : mine; }
        if (sum == G) break;
        __builtin_amdgcn_s_sleep(1);
        if ((++sp & 255u) == 0u) { if (xb_ld(&bar[XB_TMO])) break; if (sp > XB_SPIN_CAP) { atomicAdd(&bar[XB_TMO], 1u); break; } }
    }
    nloc = mine > 0u ? mine : 1u; nx = cnt > 0u ? cnt : 1u;
}

__device__ __forceinline__ void xcd_barrier(const XcdBarrier& b) {
    asm volatile("s_waitcnt vmcnt(0)" ::: "memory");
    __syncthreads();
    if (threadIdx.x == 0) {
        unsigned* bar = b.bar;
        __builtin_amdgcn_s_waitcnt(0);
        unsigned nloc = b.st[0], nx = b.st[1];
        if (nloc == 0u) { xcd_barrier_complete(bar, b.x, nloc, nx); b.st[0] = nloc; b.st[1] = nx; }
        const unsigned old = xb_add(&bar[XB_XSUB(b.x)], 1u);
        const unsigned gen = old / nloc;
        if (old + 1u == (gen + 1u) * nloc) {
            __builtin_amdgcn_fence(__ATOMIC_RELEASE, "agent");
            asm volatile("s_waitcnt vmcnt(0)" ::: "memory");
            const unsigned og = xb_add(&bar[XB_TOP], 1u);
            const unsigned tg = og / nx;
            if (og + 1u == (tg + 1u) * nx) xb_add(&bar[XB_TOPGEN], 1u);
            else XB_SPIN(xb_ld(&bar[XB_TOPGEN]) == tg, bar);
            __builtin_amdgcn_fence(__ATOMIC_ACQUIRE, "agent");
            xb_add(&bar[XB_XGEN(b.x)], 1u);
            asm volatile("s_waitcnt vmcnt(0)" ::: "memory");
        } else {
            XB_SPIN(xb_ld(&bar[XB_XGEN(b.x)]) == gen, bar);
            __builtin_amdgcn_fence(__ATOMIC_ACQUIRE, "agent");
            asm volatile("s_waitcnt vmcnt(0)" ::: "memory");
        }
    }
    __syncthreads();
}
static_assert((size_t)(CW_BAR + XCD_BAR_WORDS) * 4 <= CTL_ZERO_BYTES, "the per-call memset covers the barrier words");

__device__ __forceinline__ float wave_sum(float v) {
#pragma unroll
    for (int o = 1; o < 64; o <<= 1) v += __shfl_xor(v, o);
    return v;
}

struct Frame {
    LAS unsigned char* lds;
    volatile LAS unsigned* MISC;
    gu32* ctl;
    int tid, lane, wave, vcu, G;
    const float *x_prompt, *x_sample, *c_lat, *cache_ak, *cache_av, *cache_bk, *cache_bv, *c_ctx, *w_ada, *b_ada, *norm_g, *w_in_attn, *a_sink, *b_rpb, *w_out_attn, *w_in_pool, *w_grp, *pool_scale, *w_out_pool, *final_g;
    float* out;
    float *modp, *modf, *sA1, *sW, *sW2; bf16 *X1, *X2; unsigned char *Wq, *Wq2;
    float* rope_tab;
    bf16 *Wt_in, *Wt_kv, *Wt_out, *Wt_pin, *Wt_grp, *Wt_pout, *Wu, *H16, *cak, *cav, *cbk, *cbv, *H, *QKVG, *ATT;
};

struct TItem { const float* src; unsigned char* d8; bf16* d16; int N, perm; };
constexpr int TI_IN = (D / 64) * (NIN / 64), TI_OUT = (D / 64) * (D / 64), TI_PIN = (D / 64) * (D / 64), TI_GRP1 = (1024 / 64) * (1024 / 64), TI_POUT = TI_OUT;
constexpr int TI_TOTAL = TI_IN + TI_OUT + TI_PIN + 4 * TI_GRP1 + TI_POUT;
__device__ __forceinline__ int rope_row(int n) { const int L = n & 255, head = L >> 7, blk = (L >> 6) & 1, half = (L >> 5) & 1, i = L & 31; return (n & ~255) + half * 128 + head * 64 + blk * 32 + i; }
__device__ __forceinline__ int kv_compact(int n) { return n < C_QB ? n - C_KA : n - C_KB + 1024; }
__device__ __forceinline__ TItem titem(Frame& F, int it, int& ld16) {
    const float* W; int N, ncols; int r = it; int kind;
    bf16* WT = nullptr;
    ld16 = LDA;
    if (r < TI_IN) { W = F.w_in_attn; N = NIN; ncols = NIN; kind = 0; }
    else if ((r -= TI_IN) < TI_OUT) { W = F.w_out_attn; N = D; ncols = D; kind = 1; }
    else if ((r -= TI_OUT) < TI_PIN) { W = F.w_in_pool + D; WT = F.Wt_pin + (size_t)D * LDA; N = NPIN; ncols = D; kind = 2; }
    else if ((r -= TI_PIN) < 4 * TI_GRP1) { const int g = r / TI_GRP1; r -= g * TI_GRP1; W = F.w_grp + (size_t)g * 1024 * 1024; WT = F.Wt_grp + (size_t)g * 1024 * LDG; N = 1024; ncols = 1024; ld16 = LDG; kind = 2; }
    else { r -= 4 * TI_GRP1; W = F.w_out_pool; WT = F.Wt_pout; N = D; ncols = D; kind = 2; }
    const int nblk = ncols / 64, kb = r / nblk, nb = r % nblk, n0 = 64 * nb, k0 = 64 * kb;
    TItem t; t.src = W + (size_t)k0 * N + n0; t.N = N; t.d8 = nullptr; t.d16 = nullptr; t.perm = -1;
    if (kind == 0) { t.d8 = (unsigned char*)F.Wt_in + (size_t)n0 * LD8 + k0; if (n0 < C_VA) { t.d8 = (unsigned char*)F.Wt_in + k0; t.perm = n0; }
        const bool kv = (n0 >= C_KA && n0 < C_QB) || (n0 >= C_KB && n0 < C_GATE); if (kv) t.d16 = F.Wt_kv + (size_t)kv_compact(n0) * LDA + k0; }
    else if (kind == 1) t.d8 = (unsigned char*)F.Wt_out + (size_t)n0 * LD8 + k0;
    else t.d16 = WT + (size_t)n0 * ld16 + k0;
    return t;
}
__device__ __forceinline__ void titem_load(f32x4 (&v)[16], const TItem& t, int lane) {
    const int q = lane >> 4, n4 = (lane & 15) * 4;
#pragma unroll
    for (int i = 0; i < 16; ++i) v[i] = __builtin_nontemporal_load((const GAS f32x4*)(t.src + (size_t)(4 * i + q) * t.N + n4));
}
__device__ __forceinline__ void titem_store(const f32x4 (&v)[16], const TItem& t, int ld16, LAS float* scr, int lane) {
    const int q = lane >> 4, n4 = (lane & 15) * 4;
#pragma unroll
    for (int i = 0; i < 16; ++i) { LAS float* d = scr + (4 * i + q) * 65 + n4; d[0] = v[i].x; d[1] = v[i].y; d[2] = v[i].z; d[3] = v[i].w; }
    LDS_WAIT(); asm volatile("" ::: "memory");
    const int c = lane & 7;
#pragma unroll
    for (int j = 0; j < 8; ++j) { const int n = (lane >> 3) + 8 * j; const LAS float* s = scr + (8 * c) * 65 + n;
        if (t.d8) { v2u o; o.x = pk4_fp8(s[0 * 65] * S8_W, s[1 * 65] * S8_W, s[2 * 65] * S8_W, s[3 * 65] * S8_W); o.y = pk4_fp8(s[4 * 65] * S8_W, s[5 * 65] * S8_W, s[6 * 65] * S8_W, s[7 * 65] * S8_W);
            *(GAS v2u*)(t.d8 + (size_t)(t.perm >= 0 ? rope_row(t.perm + n) : n) * LD8 + 8 * c) = o; }
        if (t.d16) { v4u o; o.x = pk2(s[0 * 65], s[1 * 65]); o.y = pk2(s[2 * 65], s[3 * 65]); o.z = pk2(s[4 * 65], s[5 * 65]); o.w = pk2(s[6 * 65], s[7 * 65]);
            *(GAS v4u*)(t.d16 + (size_t)n * ld16 + 8 * c) = o; } }
    LDS_WAIT(); asm volatile("" ::: "memory");
}
constexpr int ADA_NC = NMOD / 256, ADA_ITEMS = 2 * KSPLIT * ADA_NC, ADA_KS = D / KSPLIT;
__device__ __forceinline__ void p0_ada_item(Frame& F, int a) {
    const int l = a / (KSPLIT * ADA_NC), rem = a % (KSPLIT * ADA_NC), s = rem / ADA_NC, nc = rem % ADA_NC;
    const int k0 = s * ADA_KS, n0 = nc * 256 + F.lane * 4;
    f32x4 acc[NCOND];
#pragma unroll
    for (int j = 0; j < NCOND; ++j) acc[j] = (f32x4){0.f, 0.f, 0.f, 0.f};
    const float* wp = F.w_ada + ((size_t)l * D + k0) * NMOD + n0;
    for (int kb = 0; kb < ADA_KS / 64; ++kb) {
        float cv[NCOND];
        cv[0] = silu(F.c_ctx[k0 + kb * 64 + F.lane]);
#pragma unroll
        for (int j = 1; j < NCOND; ++j) cv[j] = silu(F.c_lat[(size_t)(j - 1) * D + k0 + kb * 64 + F.lane]);
#pragma unroll 16
        for (int kk = 0; kk < 64; ++kk) {
            const f32x4 w = __builtin_nontemporal_load((const f32x4*)(wp + (size_t)(kb * 64 + kk) * NMOD));
#pragma unroll
            for (int j = 0; j < NCOND; ++j) { const float cj = __builtin_bit_cast(float, __builtin_amdgcn_readlane(__builtin_bit_cast(int, cv[j]), kk)); acc[j] += w * cj; }
        }
    }
#pragma unroll
    for (int j = 0; j < NCOND; ++j) *(f32x4*)(F.modp + (((size_t)s * 2 + l) * NCOND + j) * NMOD + n0) = acc[j];
}
__device__ __forceinline__ void p0_prologue(Frame& F) {
    LAS float* scr = (LAS float*)(F.lds + RING_OFF + F.wave * 16640);
    const int gw = F.vcu * NWAVES + F.wave, NGW = F.G * NWAVES;
    for (int a = gw; a < ADA_ITEMS; a += NGW) p0_ada_item(F, a);
    int n, base, stride, off;
    if (NGW == 2048) { const bool ada = gw < ADA_ITEMS; n = ada ? 11 : 19; base = ada ? 0 : ADA_ITEMS * 11; stride = ada ? ADA_ITEMS : 2048 - ADA_ITEMS; off = ada ? gw : gw - ADA_ITEMS; }
    else { n = (TI_TOTAL - gw + NGW - 1) / NGW; base = 0; stride = NGW; off = gw; }
    if (n > 0) {
        f32x4 va[16], vb[16]; int la = LDA, lb = LDA;
        TItem ta = titem(F, base + off, la), tb = ta;
        titem_load(va, ta, F.lane);
        for (int i = 0; i < n; i += 2) {
            if (i + 1 < n) { tb = titem(F, base + (i + 1) * stride + off, lb); titem_load(vb, tb, F.lane); }
            titem_store(va, ta, la, scr, F.lane);
            if (i + 1 < n) {
                if (i + 2 < n) { ta = titem(F, base + (i + 2) * stride + off, la); titem_load(va, ta, F.lane); }
                titem_store(vb, tb, lb, scr, F.lane);
            }
        }
    }
    if (blockIdx.x == 0) for (int e = F.tid; e < 64 * 32; e += NTHREADS) {
        const int pos = e >> 5, i = e & 31; const float invf = exp2f(-(float)i * (13.287712379549449f / 32.0f));
        float sn, cs; sincosf((float)pos * invf, &sn, &cs); F.rope_tab[e] = cs; F.rope_tab[2048 + e] = sn; }
    for (int k = gw; k < D; k += NGW) {
        const float* src = F.w_in_pool + (size_t)k * NPIN; bf16* dst = F.Wu + (size_t)k * LDA;
#pragma unroll
        for (int q = 0; q < 8; ++q) { const int c = q * 512 + F.lane * 8; const f32x4 a = *(const GAS f32x4*)(src + c), b = *(const GAS f32x4*)(src + c + 4);
            v4u w; w.x = pk2(a.x, a.y); w.y = pk2(a.z, a.w); w.z = pk2(b.x, b.y); w.w = pk2(b.z, b.w); *(GAS v4u*)(dst + c) = w; }
    }
}

template <bool PART, class TX> __device__ __forceinline__ void norm_phase(Frame& F, const TX* xP, const TX* xS, const float* gvec, int layer) {
    LAS float* tA = (LAS float*)(F.lds + RING_OFF); LAS float* tB = tA + D;
    for (int rg = blockIdx.x; rg < M_TOK / 64; rg += F.G) {
        const int j = rg < NCTX / 64 ? 0 : 1 + (rg - NCTX / 64) / (LAT_L / 64);
        __syncthreads();
        for (int c = F.tid; c < D; c += NTHREADS) {
            float sh, sc;
            if (PART) { sh = F.b_ada[(size_t)layer * NMOD + c]; sc = F.b_ada[(size_t)layer * NMOD + D + c];
                for (int s = 0; s < KSPLIT; ++s) { const float* p = F.modp + (((size_t)s * 2 + layer) * NCOND + j) * NMOD; sh += p[c]; sc += p[D + c]; } }
            else { const float* p = F.modf + ((size_t)layer * NCOND + j) * NMOD; sh = p[c]; sc = p[D + c]; }
            tA[c] = gvec[c] * (1.0f + sc); tB[c] = sh;
        }
        __syncthreads();
        for (int i = 0; i < 8; ++i) {
            const int row = rg * 64 + F.wave * 8 + i;
            const TX* xr = row < NCTX ? xP + (size_t)row * D : xS + (size_t)(row - NCTX) * D;
            f32x4 v[16]; float ss = 0.f;
#pragma unroll
            for (int q = 0; q < 16; ++q) { if constexpr (sizeof(TX) == 4) v[q] = *(const f32x4*)(xr + q * 256 + F.lane * 4); else { const v2u w = *(const v2u*)(xr + q * 256 + F.lane * 4); v[q] = (f32x4){bflo(w.x), bfhi(w.x), bflo(w.y), bfhi(w.y)}; }
                ss += (v[q].x * v[q].x + v[q].y * v[q].y) + (v[q].z * v[q].z + v[q].w * v[q].w); }
            const float rstd = rsqrtf(wave_sum(ss) * (1.0f / D) + NORM_EPS);
            bf16* orow = F.H16 + (size_t)row * LDA; unsigned char* orow8 = (unsigned char*)F.H + (size_t)row * LD8;
            if (PART) {
                const bool w16 = row < NCTX;
#pragma unroll
                for (int q = 0; q < 16; ++q) { const int c = q * 256 + F.lane * 4; const f32x4 a = *(const LAS f32x4*)(tA + c), b = *(const LAS f32x4*)(tB + c);
                    const f32x4 o = v[q] * rstd * a + b;
                    if (w16) { v2u w; w.x = pk2(o.x, o.y); w.y = pk2(o.z, o.w); *(v2u*)(orow + c) = w; }
                    *(unsigned*)(orow8 + c) = pk4_fp8(o.x * S8_H, o.y * S8_H, o.z * S8_H, o.w * S8_H); }
            } else {
                float mx = 1e-20f;
#pragma unroll
                for (int q = 0; q < 16; ++q) { const int c = q * 256 + F.lane * 4; const f32x4 a = *(const LAS f32x4*)(tA + c), b = *(const LAS f32x4*)(tB + c);
                    v[q] = v[q] * rstd * a + b; mx = fmaxf(mx, fmaxf(fmaxf(fabsf(v[q].x), fabsf(v[q].y)), fmaxf(fabsf(v[q].z), fabsf(v[q].w)))); }
#pragma unroll
                for (int off = 1; off < 64; off <<= 1) mx = fmaxf(mx, __shfl_xor(mx, off));
                const float qi = 127.0f / mx;
                if (F.lane == 0) F.sA1[row] = mx * (1.0f / 127.0f);
#pragma unroll
                for (int q = 0; q < 16; ++q) { const int c = q * 256 + F.lane * 4; *(unsigned*)(orow8 + c) = pk4_i8(v[q].x * qi, v[q].y * qi, v[q].z * qi, v[q].w * qi); }
            }
        }
    }
    __syncthreads();
}

__device__ __forceinline__ void norm1_phase(Frame& F) {
    LAS float* tA = (LAS float*)(F.lds + RING_OFF); LAS float* tB = tA + D;
    const float* gvec = F.norm_g + D;
    for (int rg = blockIdx.x; rg < M_TOK / 64; rg += F.G) {
        const int j = rg < NCTX / 64 ? 0 : 1 + (rg - NCTX / 64) / (LAT_L / 64);
        __syncthreads();
        for (int c = F.tid; c < D; c += NTHREADS) { const float* p = F.modf + ((size_t)NCOND + j) * NMOD; tA[c] = gvec[c] * (1.0f + p[D + c]); tB[c] = p[c]; }
        __syncthreads();
#pragma unroll 1
        for (int hf = 0; hf < 4; ++hf) {
            const int row0 = rg * 64 + F.wave * 8 + hf * 2;
            v4u raw[2][8];
#pragma unroll
            for (int r = 0; r < 2; ++r) { const bf16* xr = F.X1 + (size_t)(row0 + r) * D + F.lane * 8;
#pragma unroll
                for (int k = 0; k < 8; ++k) raw[r][k] = *(const v4u*)(xr + k * 512); }
            asm volatile("" ::: "memory");
#pragma unroll
            for (int r = 0; r < 2; ++r) {
                float ss = 0.f;
#pragma unroll
                for (int k = 0; k < 8; ++k)
#pragma unroll
                    for (int e = 0; e < 4; ++e) { const float a = bflo(raw[r][k][e]), b = bfhi(raw[r][k][e]); ss += a * a + b * b; }
                const float rstd = rsqrtf(wave_sum(ss) * (1.0f / D) + NORM_EPS);
                float mx = 1e-20f;
#pragma unroll
                for (int k = 0; k < 8; ++k) { const int c = k * 512 + F.lane * 8;
                    const f32x4 a0 = *(const LAS f32x4*)(tA + c), a1 = *(const LAS f32x4*)(tA + c + 4), b0 = *(const LAS f32x4*)(tB + c), b1 = *(const LAS f32x4*)(tB + c + 4);
                    const v4u w = raw[r][k];
                    const f32x4 o0 = (f32x4){bflo(w[0]), bfhi(w[0]), bflo(w[1]), bfhi(w[1])} * rstd * a0 + b0, o1 = (f32x4){bflo(w[2]), bfhi(w[2]), bflo(w[3]), bfhi(w[3])} * rstd * a1 + b1;
                    mx = fmaxf(mx, fmaxf(fmaxf(fmaxf(fabsf(o0.x), fabsf(o0.y)), fmaxf(fabsf(o0.z), fabsf(o0.w))), fmaxf(fmaxf(fabsf(o1.x), fabsf(o1.y)), fmaxf(fabsf(o1.z), fabsf(o1.w)))));
                    raw[r][k] = (v4u){pk2(o0.x, o0.y), pk2(o0.z, o0.w), pk2(o1.x, o1.y), pk2(o1.z, o1.w)}; }
#pragma unroll
                for (int off = 1; off < 64; off <<= 1) mx = fmaxf(mx, __shfl_xor(mx, off));
                const float qi = 127.0f / mx;
                if (F.lane == 0) F.sA1[row0 + r] = mx * (1.0f / 127.0f);
                unsigned char* orow8 = (unsigned char*)F.H + (size_t)(row0 + r) * LD8 + F.lane * 8;
#pragma unroll
                for (int k = 0; k < 8; ++k) { const v4u w = raw[r][k]; v2u q;
                    q.x = pk4_i8(bflo(w[0]) * qi, bfhi(w[0]) * qi, bflo(w[1]) * qi, bfhi(w[1]) * qi); q.y = pk4_i8(bflo(w[2]) * qi, bfhi(w[2]) * qi, bflo(w[3]) * qi, bfhi(w[3]) * qi);
                    *(v2u*)(orow8 + k * 512) = q; }
                asm volatile("" ::: "memory");
            }
        }
    }
    __syncthreads();
}

__device__ __forceinline__ void norm0_phase(Frame& F) {
    LAS float* tA = (LAS float*)(F.lds + RING_OFF); LAS float* tB = tA + D;
    for (int rg = blockIdx.x; rg < M_TOK / 64; rg += F.G) {
        const int j = rg < NCTX / 64 ? 0 : 1 + (rg - NCTX / 64) / (LAT_L / 64);
        __syncthreads();
        for (int c = F.tid; c < D; c += NTHREADS) {
            float sh = F.b_ada[c], sc = F.b_ada[D + c];
            for (int s = 0; s < KSPLIT; ++s) { const float* p = F.modp + (((size_t)s * 2) * NCOND + j) * NMOD; sh += p[c]; sc += p[D + c]; }
            tA[c] = F.norm_g[c] * (1.0f + sc); tB[c] = sh;
        }
        __syncthreads();
#pragma unroll 1
        for (int hf = 0; hf < 4; ++hf) {
            const int row0 = rg * 64 + F.wave * 8 + hf * 2;
            f32x4 raw[2][16];
#pragma unroll
            for (int r = 0; r < 2; ++r) { const int row = row0 + r; const float* xr = (row < NCTX ? F.x_prompt + (size_t)row * D : F.x_sample + (size_t)(row - NCTX) * D) + F.lane * 4;
#pragma unroll
                for (int q = 0; q < 16; ++q) raw[r][q] = *(const f32x4*)(xr + q * 256); }
            asm volatile("" ::: "memory");
#pragma unroll
            for (int r = 0; r < 2; ++r) { const int row = row0 + r;
                float ss = 0.f;
#pragma unroll
                for (int q = 0; q < 16; ++q) { const f32x4 v = raw[r][q]; ss += (v.x * v.x + v.y * v.y) + (v.z * v.z + v.w * v.w); }
                const float rstd = rsqrtf(wave_sum(ss) * (1.0f / D) + NORM_EPS);
                bf16* orow = F.H16 + (size_t)row * LDA; unsigned char* orow8 = (unsigned char*)F.H + (size_t)row * LD8; const bool w16 = row < NCTX;
#pragma unroll
                for (int q = 0; q < 16; ++q) { const int c = q * 256 + F.lane * 4; const f32x4 a = *(const LAS f32x4*)(tA + c), b = *(const LAS f32x4*)(tB + c);
                    const f32x4 o = raw[r][q] * rstd * a + b;
                    if (w16) { v2u w; w.x = pk2(o.x, o.y); w.y = pk2(o.z, o.w); *(v2u*)(orow + c) = w; }
                    *(unsigned*)(orow8 + c) = pk4_fp8(o.x * S8_H, o.y * S8_H, o.z * S8_H, o.w * S8_H); }
                asm volatile("" ::: "memory");
            }
        }
    }
    __syncthreads();
}
__device__ __forceinline__ void p1_extras(Frame& F) {
    const int gt = blockIdx.x * NTHREADS + F.tid, NT = F.G * NTHREADS;
    for (int idx = gt; idx < 2 * NCOND * NMOD; idx += NT) {
        const int l = idx / (NCOND * NMOD), n = idx % NMOD; float v = F.b_ada[(size_t)l * NMOD + n];
        for (int s = 0; s < KSPLIT; ++s) v += F.modp[(size_t)s * 2 * NCOND * NMOD + idx];
        F.modf[idx] = v;
    }
}
__device__ __forceinline__ void cache_convert(Frame& F, int wt, int WT) {
    constexpr size_t NA8 = (size_t)LAT_B * PAST * 512 / 8, NB8 = (size_t)LAT_B * PAST * 2048 / 8, NTOT = 2 * NA8 + 2 * NB8;
    for (size_t i0 = wt; i0 < NTOT; i0 += (size_t)4 * WT) {
        f32x4 a[4], b[4]; bf16* dp[4];
#pragma unroll
        for (int u = 0; u < 4; ++u) { const size_t i = i0 + (size_t)u * WT; dp[u] = nullptr;
            if (i < NTOT) { const float* src; bf16* dst; size_t k = i;
                if (k < NA8) { src = F.cache_ak; dst = F.cak; } else if ((k -= NA8) < NA8) { src = F.cache_av; dst = F.cav; } else if ((k -= NA8) < NB8) { src = F.cache_bk; dst = F.cbk; } else { k -= NB8; src = F.cache_bv; dst = F.cbv; }
                a[u] = *(const f32x4*)(src + k * 8); b[u] = *(const f32x4*)(src + k * 8 + 4);
                const int lc = dst == F.cak || dst == F.cav ? 9 : 11;
                const size_t e = k * 8, row = e >> lc, col = e & (((size_t)1 << lc) - 1);
                dp[u] = dst + (col >> 7) * ((size_t)LAT_B * PAST * HD) + row * HD + (col & 127); } }
#pragma unroll
        for (int u = 0; u < 4; ++u) if (dp[u]) { v4u w; w.x = pk2(a[u].x, a[u].y); w.y = pk2(a[u].z, a[u].w); w.z = pk2(b[u].x, b[u].y); w.w = pk2(b[u].z, b[u].w); *(v4u*)dp[u] = w; }
    }
}


__device__ __forceinline__ void quant_weight_rows(Frame& F, const bf16* src, unsigned char* dst, float* sc, int nrows, int gw, int NGW) {
    for (int r0 = gw; r0 < nrows; r0 += 2 * NGW) {
        v4u x[2][8]; const int r1 = r0 + NGW < nrows ? r0 + NGW : r0;
#pragma unroll
        for (int q = 0; q < 8; ++q) { x[0][q] = *(const v4u*)(src + (size_t)r0 * LDA + q * 512 + F.lane * 8); x[1][q] = *(const v4u*)(src + (size_t)r1 * LDA + q * 512 + F.lane * 8); }
#pragma unroll
        for (int u = 0; u < 2; ++u) { const int r = u ? r1 : r0; if (u && r1 == r0) break;
            float mx = 1e-20f;
#pragma unroll
            for (int q = 0; q < 8; ++q)
#pragma unroll
                for (int e = 0; e < 4; ++e) mx = fmaxf(mx, fmaxf(fabsf(bflo(x[u][q][e])), fabsf(bfhi(x[u][q][e]))));
#pragma unroll
            for (int off = 1; off < 64; off <<= 1) mx = fmaxf(mx, __shfl_xor(mx, off));
            const float qi = 127.0f / mx; if (F.lane == 0) sc[r] = mx * (1.0f / 127.0f);
            unsigned char* o = dst + (size_t)r * LD8;
#pragma unroll
            for (int q = 0; q < 8; ++q) { v2u w; w.x = pk4_i8(bflo(x[u][q][0]) * qi, bfhi(x[u][q][0]) * qi, bflo(x[u][q][1]) * qi, bfhi(x[u][q][1]) * qi); w.y = pk4_i8(bflo(x[u][q][2]) * qi, bfhi(x[u][q][2]) * qi, bflo(x[u][q][3]) * qi, bfhi(x[u][q][3]) * qi);
                *(v2u*)(o + q * 512 + F.lane * 8) = w; } }
    }
}

__device__ __forceinline__ void side_jobs(Frame& F, int gw, int NGW) {
    quant_weight_rows(F, F.Wt_pin, F.Wq, F.sW, NPIN, gw, NGW); quant_weight_rows(F, F.Wt_pout, F.Wq2, F.sW2, D, gw, NGW);
    cache_convert(F, gw * 64 + F.lane, NGW * 64);
}
__device__ __forceinline__ att::Unit attn_make_unit(Frame& F, int w, int e) {
    const int kind = w >> 8, p = w & 255, idx = 2 * p + e;
    att::Unit u;
    u.kc = nullptr; u.vc = nullptr; u.nctx = 0; u.mask = 0; u.qpos0 = 0; u.kpos0 = 0; u.has_sink = 0; u.sink_i = 0; u.rpb = F.b_rpb;
    if (kind < 2) {
        const int b = idx >> 4, h = idx & 15; const size_t row0 = (size_t)b * CTX_L;
        const int qc = kind ? C_QB + h * HD : C_QA + h * HD, kcol = kind ? C_KB + h * HD : C_KA + (h >> 2) * HD, vcol = kind ? C_VB + h * HD : C_VA + (h >> 2) * HD, oc = kind * 2048 + h * HD;
        u.q = F.QKVG + qoff(row0, qc); u.kl = F.QKVG + qoff(row0, kcol); u.vl = F.QKVG + qoff(row0, vcol); u.nt = 4;
        if (kind == 0) { u.has_sink = 1; u.sink_i = h; }
        u.gate = F.QKVG + qoff(row0, C_GATE + oc); u.out = (unsigned char*)F.ATT + row0 * LD8 + oc;
    } else {
        const int qb = idx & 3, h = (idx >> 2) & 15, b = idx >> 6; const size_t seq0 = (size_t)NCTX + (size_t)b * LAT_L, row0 = seq0 + qb * 256;
        u.nctx = 8;
        if (kind == 2) {
            const int kstart = qb == 0 ? 0 : qb * 256 - 128, nloc = (qb == 0 || qb == 3) ? 6 : 8, kvh = h >> 2;
            u.q = F.QKVG + qoff(row0, C_QA + h * HD);
            u.kc = F.cak + ((size_t)kvh * LAT_B + b) * PAST * HD; u.vc = F.cav + ((size_t)kvh * LAT_B + b) * PAST * HD;
            u.kl = F.QKVG + qoff(seq0 + kstart, C_KA + kvh * HD); u.vl = F.QKVG + qoff(seq0 + kstart, C_VA + kvh * HD);
            u.nt = 8 + nloc; u.mask = 1; u.qpos0 = qb * 256; u.kpos0 = kstart; u.has_sink = 1; u.sink_i = h;
            u.gate = F.QKVG + qoff(row0, C_GATE + h * HD); u.out = (unsigned char*)F.ATT + row0 * LD8 + h * HD;
        } else {
            const int krow0 = qb < 2 ? 0 : (qb == 2 ? 4 : 8), nloc = (qb == 0 || qb == 3) ? 8 : 12;
            u.q = F.QKVG + qoff(row0, C_QB + h * HD);
            u.kc = F.cbk + ((size_t)h * LAT_B + b) * PAST * HD; u.vc = F.cbv + ((size_t)h * LAT_B + b) * PAST * HD;
            u.kl = F.QKVG + qoff(seq0 + krow0 * GRID_W, C_KB + h * HD); u.vl = F.QKVG + qoff(seq0 + krow0 * GRID_W, C_VB + h * HD);
            u.nt = 8 + nloc; u.mask = 2; u.qpos0 = qb * 4; u.kpos0 = krow0; u.rpb = F.b_rpb + (size_t)h * 15 * 31;
            u.gate = F.QKVG + qoff(row0, C_GATE + 2048 + h * HD); u.out = (unsigned char*)F.ATT + row0 * LD8 + 2048 + h * HD;
        }
    }
    return u;
}
__device__ __forceinline__ void attn_phase(Frame& F, char* lds, int wlimit = 1024) {
    const int nw = F.vcu < wlimit ? (wlimit - 1 - F.vcu) / F.G + 1 : 0, n = 2 * nw;
    if (n == 0) return;
    att::Regs R;
    if (F.tid < 16) ((float*)(lds + att::OFF_SINK))[F.tid] = F.a_sink[F.tid];
    const int rot = n == 8 ? 2 * ((F.vcu >> 3) & 3) : 0;
#define ATT_UNIT_OF(k_) attn_make_unit(F, F.vcu + ((n == 8 ? ((k_) + rot) & 7 : (k_)) >> 1) * F.G, (k_) & 1)
    att::Unit cur = ATT_UNIT_OF(0), nxt = cur;
    att::attn_prefetch(cur, R);
    for (int k = 0; k < n; ++k) {
        const bool has_next = k + 1 < n;
        if (has_next) nxt = ATT_UNIT_OF(k + 1);
        att::attn_unit(cur, has_next, nxt, R, lds, k > 0);
        cur = nxt;
    }
    att::attn_flush(R);
#undef ATT_UNIT_OF
}

__device__ __forceinline__ void pool_phase(Frame& F) {
    typedef float f32x2 __attribute__((ext_vector_type(2)));
    LAS float* pss = (LAS float*)(F.lds + RING_OFF);
    LAS float* qinv = pss + 16 * NTHREADS;
    const bf16* U = F.QKVG; unsigned char* Yq = (unsigned char*)F.ATT;
    const int col = F.tid * 8, half = 1 << (col >> 10);
    f32x2 psc2[4];
#pragma unroll
    for (int e = 0; e < 4; ++e) psc2[e] = (f32x2){F.pool_scale[col + 2 * e], F.pool_scale[col + 2 * e + 1]};
    for (int chunk = blockIdx.x; chunk < M_TOK / 64; chunk += F.G) {
        const int m0 = chunk * 64; int seq0, n;
        if (m0 < NCTX) { seq0 = m0 & ~(CTX_L - 1); n = CTX_L; } else { seq0 = NCTX + ((m0 - NCTX) & ~(LAT_L - 1)); n = LAT_L; }
        const int tl0 = m0 - seq0; const bf16* up = U + (size_t)seq0 * NPIN + col;
        f32x2 S2[4];
#pragma unroll
        for (int e = 0; e < 4; ++e) S2[e] = (f32x2){0.f, 0.f};
        { const int lo = tl0 - half < 0 ? 0 : tl0 - half, hi = tl0 + half > n ? n : tl0 + half;
          for (int tt = lo; tt < hi; ++tt) { const v4u ww = *(const v4u*)(up + (size_t)tt * NPIN);
#pragma unroll
              for (int e = 0; e < 4; ++e) S2[e] = S2[e] + (f32x2){bflo(ww[e]), bfhi(ww[e])}; } }
#pragma unroll 1
        for (int sub = 0; sub < 4; ++sub) {
            v4u yb[16];
#pragma unroll
            for (int grp = 0; grp < 4; ++grp) {
                const int tg = tl0 + sub * 16 + grp * 4;
                v4u cur[4], gat[4], add[4], rem[4];
#pragma unroll
                for (int j = 0; j < 4; ++j) { const int t = tg + j; const int ta = t + half < n ? t + half : t, tr = t - half >= 0 ? t - half : t;
                    cur[j] = *(const v4u*)(up + (size_t)t * NPIN); gat[j] = *(const v4u*)(up + (size_t)t * NPIN + D);
                    add[j] = *(const v4u*)(up + (size_t)ta * NPIN); rem[j] = *(const v4u*)(up + (size_t)tr * NPIN); }
                asm volatile("" ::: "memory");
#pragma unroll
                for (int j = 0; j < 4; ++j) { const int t = tg + j;
                    const int lo = t - half < 0 ? 0 : t - half, hi = t + half > n ? n : t + half; const float inv = __builtin_amdgcn_rcpf((float)(hi - lo));
                    const bool ha = t + half < n, hr = t - half >= 0;
                    float ss = 0.f;
#pragma unroll
                    for (int e = 0; e < 4; ++e) {
                        const f32x2 u2 = {bflo(cur[j][e]), bfhi(cur[j][e])}, g2 = {bflo(gat[j][e]), bfhi(gat[j][e])};
                        const f32x2 m2 = (S2[e] * inv - u2) * psc2[e];
                        const f32x2 t2 = g2 * -1.4426950408889634f; f32x2 d2 = {__builtin_amdgcn_exp2f(t2.x), __builtin_amdgcn_exp2f(t2.y)}; d2 = d2 + 1.0f;
                        const f32x2 r2 = {__builtin_amdgcn_rcpf(d2.x), __builtin_amdgcn_rcpf(d2.y)}, y2 = m2 * (g2 * r2);
                        ss = fmaxf(ss, fmaxf(fabsf(y2.x), fabsf(y2.y)));
                        yb[grp * 4 + j][e] = pk2(y2.x, y2.y);
                        const unsigned aw = ha ? add[j][e] : 0u, rw = hr ? rem[j][e] : 0u;
                        S2[e] = S2[e] + ((f32x2){bflo(aw), bfhi(aw)} - (f32x2){bflo(rw), bfhi(rw)}); }
                    pss[(grp * 4 + j) * NTHREADS + F.tid] = ss; }
                asm volatile("" ::: "memory");
            }
            __syncthreads();
            { const int tok = F.tid >> 5, part = F.tid & 31; float a = 0.f;
#pragma unroll
              for (int i = 0; i < 16; ++i) a = fmaxf(a, pss[tok * NTHREADS + part * 16 + i]);
#pragma unroll
              for (int off = 1; off < 32; off <<= 1) a = fmaxf(a, __shfl_xor(a, off));
              if (part == 0) { const float step = fmaxf(a, 1e-20f) * (1.0f / 127.0f); qinv[tok] = 1.0f / step; F.sA1[seq0 + tl0 + sub * 16 + tok] = step; } }
            __syncthreads();
#pragma unroll
            for (int j = 0; j < 16; ++j) { const float qi = qinv[j]; float q[8];
#pragma unroll
                for (int e = 0; e < 4; ++e) { q[2 * e] = bflo(yb[j][e]) * qi; q[2 * e + 1] = bfhi(yb[j][e]) * qi; }
                v2u w; w.x = pk4_i8(q[0], q[1], q[2], q[3]); w.y = pk4_i8(q[4], q[5], q[6], q[7]);
                *(v2u*)(Yq + (size_t)(seq0 + tl0 + sub * 16 + j) * LD8 + col) = w; }
        }
    }
    __syncthreads();
}

__device__ __forceinline__ void final_norm_phase(Frame& F) {
    const int gw = F.vcu * NWAVES + F.wave, NGW = F.G * NWAVES;
    v2u raw[16];
    if (gw < M_TOK) { const bf16* xr = F.X2 + (size_t)gw * D;
#pragma unroll
        for (int q = 0; q < 16; ++q) raw[q] = *(const v2u*)(xr + q * 256 + F.lane * 4); }
    for (int row = gw; row < M_TOK; row += NGW) {
        float* yr = F.out + OFF_Y + (size_t)row * D;
        f32x4 v[16]; float ss = 0.f;
#pragma unroll
        for (int q = 0; q < 16; ++q) { const v2u w = raw[q]; v[q] = (f32x4){bflo(w.x), bfhi(w.x), bflo(w.y), bfhi(w.y)}; ss += (v[q].x * v[q].x + v[q].y * v[q].y) + (v[q].z * v[q].z + v[q].w * v[q].w); }
        if (row + NGW < M_TOK) { const bf16* xn = F.X2 + (size_t)(row + NGW) * D;
#pragma unroll
            for (int q = 0; q < 16; ++q) raw[q] = *(const v2u*)(xn + q * 256 + F.lane * 4); }
        const float rstd = rsqrtf(wave_sum(ss) * (1.0f / D) + NORM_EPS);
#pragma unroll
        for (int q = 0; q < 16; ++q) { const int c = q * 256 + F.lane * 4; const f32x4 g = *(const f32x4*)(F.final_g + c); *(f32x4*)(yr + c) = v[q] * rstd * g; }
    }
}

constexpr int N_PHASES = 12;
constexpr int N_LAUNCHES = MK_N_LAUNCHES;
struct Args { const float* in[20]; float* out; unsigned char* ws; int ph_lo, ph_hi; };
static_assert(sizeof(Args) == 20 * 8 + 8 + 8 + 8, "Args has no padding");
__global__ void __launch_bounds__(NTHREADS, 2) fwd_kernel(Args args) {
    extern __shared__ __attribute__((aligned(16))) unsigned char lds[];
    Frame F;
    F.lds = (LAS unsigned char*)lds;
    F.MISC = (volatile LAS unsigned*)(F.lds + MISC_OFF);
    F.tid = threadIdx.x; F.lane = F.tid & 63; F.wave = __builtin_amdgcn_readfirstlane(F.tid >> 6);
    F.G = gridDim.x; { const int bx = blockIdx.x; F.vcu = (F.G % 8 == 0) ? (bx % 8) * (F.G / 8) + bx / 8 : bx; }
    unsigned char* ws = args.ws;
    F.ctl = (gu32*)(ws + WS_CTL);
    F.x_prompt = args.in[0]; F.x_sample = args.in[1]; F.c_lat = args.in[2]; F.cache_ak = args.in[3]; F.cache_av = args.in[4]; F.cache_bk = args.in[5]; F.cache_bv = args.in[6];
    F.c_ctx = args.in[7]; F.w_ada = args.in[8]; F.b_ada = args.in[9]; F.norm_g = args.in[10]; F.w_in_attn = args.in[11]; F.a_sink = args.in[12]; F.b_rpb = args.in[13];
    F.w_out_attn = args.in[14]; F.w_in_pool = args.in[15]; F.w_grp = args.in[16]; F.pool_scale = args.in[17]; F.w_out_pool = args.in[18]; F.final_g = args.in[19];
    F.out = args.out;
    F.modp = (float*)(ws + WS_MODP); F.modf = (float*)(ws + WS_MODF); F.X1 = (bf16*)(ws + WS_X1); F.X2 = (bf16*)(ws + WS_X2); F.sA1 = (float*)(ws + WS_SCL); F.sW = F.sA1 + M_TOK; F.sW2 = F.sW + NPIN; F.Wq = ws + WS_WQ; F.Wq2 = ws + WS_WQ2;
    F.Wt_in = (bf16*)(ws + WS_WIN); F.Wt_kv = (bf16*)(ws + WS_WKV); F.H16 = (bf16*)(ws + WS_H16); F.Wt_out = (bf16*)(ws + WS_WOUT); F.Wt_pin = (bf16*)(ws + WS_WPIN); F.Wt_grp = (bf16*)(ws + WS_WGRP); F.Wt_pout = (bf16*)(ws + WS_WPOUT); F.Wu = (bf16*)(ws + WS_WU);
    F.cak = (bf16*)(ws + WS_CAK); F.cav = (bf16*)(ws + WS_CAV); F.cbk = (bf16*)(ws + WS_CBK); F.cbv = (bf16*)(ws + WS_CBV);
    F.rope_tab = (float*)(ws + WS_ROPE);
    F.H = (bf16*)(ws + WS_H); F.QKVG = (bf16*)(ws + WS_QKVG); F.ATT = (bf16*)(ws + WS_ATT);
    for (int u = F.tid; u < (LDS_BYTES - LDSCTL_OFF) / 4; u += NTHREADS) ((LAS unsigned*)(F.lds + LDSCTL_OFF))[u] = 0u;
    __syncthreads();
    XcdBarrier bar; bar.bar = (unsigned*)(F.ctl + CW_BAR); bar.x = 0; bar.st = nullptr;
    if (N_LAUNCHES == 1) bar = xcd_barrier_post((unsigned*)(F.ctl + CW_BAR), F.MISC + 8);
#define GRID_BAR() do { if (N_LAUNCHES == 1) xcd_barrier(bar); } while (0)
    const int lo = args.ph_lo, hi = args.ph_hi;
#define REFRESH() do { int t_ = threadIdx.x; asm volatile("" : "+v"(t_)); F.tid = t_; F.lane = t_ & 63; F.wave = __builtin_amdgcn_readfirstlane(t_ >> 6); } while (0)
#ifndef PROBE_REP
#define PROBE_REP -1
#endif
#ifndef PROBE_ATT_LIMIT
#define PROBE_ATT_LIMIT 1024
#endif
#define IN(k) (lo <= (k) && (k) < hi)
#define REPS(k) for (int rep_ = 0; rep_ < ((k) == PROBE_REP ? 2 : 1); ++rep_)
#define BOTH(k) (IN(k) && IN((k) + 1))
    typedef pg8::bf16_t pb;

    if (IN(0)) REPS(0) { REFRESH(); if (rep_) GRID_BAR(); p0_prologue(F); if (BOTH(0)) GRID_BAR(); }
    if (IN(1)) REPS(1) { REFRESH(); if (rep_) GRID_BAR(); p1_extras(F); norm0_phase(F);
        {
            pg8::Gemm g{(const pb*)F.Wt_grp, (const pb*)F.Wu, D, D, 1024, LDG, LDA, 0, 4}; pg8::StaticOrder S; S.init(D, D, F.G, (int)blockIdx.x);
            pg8::EpiBf16 E{(pb*)F.Wt_pin, LDA, 128, 1.0f};
            pg8::gemm_phase<pg8::EpiBf16, pg8::StaticOrder, true, true>(F.lds + RING_OFF, g, S, E);
        }
        if (BOTH(1)) GRID_BAR(); }
    if (IN(2)) REPS(2) { REFRESH(); if (rep_) GRID_BAR();
        for (int e = F.tid; e < 4096; e += NTHREADS) ((LAS float*)(F.lds + ROPE_LDS_OFF))[(e >> 5) * pg8::ROPE_LD + (e & 31)] = F.rope_tab[e];
        __syncthreads();
        {
            pg8::Gemm g{(const pb*)F.H16, (const pb*)F.Wt_kv, NCTX, 5120, D, LDA, LDA, 0, 0}; pg8::StaticOrder S; S.init(NCTX, 5120, F.G, F.G - 1 - (int)blockIdx.x);
            pg8::EpiKV E{(pb*)F.QKVG, HD, QBLK_STRIDE, F.out + OFF_NAK, F.out + OFF_NAV, F.out + OFF_NBK, F.out + OFF_NBV};
            pg8::gemm_phase<pg8::EpiKV, pg8::StaticOrder, true, true>(F.lds + RING_OFF, g, S, E);
        }
        {
            pg8::Gemm g{(const pb*)F.H, (const pb*)F.Wt_in, M_TOK, NIN, D, LD8, LD8, 0, 0}; pg8::MixedOrder S; S.init(F.G, (int)blockIdx.x);
            pg8::EpiQKVG E{(pb*)F.QKVG, HD, QBLK_STRIDE, 1.0f / (S8_H * S8_W), (const PG8_LAS float*)(F.lds + ROPE_LDS_OFF)};
            pg8::gemm_phase<pg8::EpiQKVG, pg8::MixedOrder, true, true, 1>(F.lds + RING_OFF, g, S, E);
        }
#ifndef PROBE_SIDE
#define PROBE_SIDE 1
#endif
        if (F.G == 256 && blockIdx.x >= 128) { REFRESH(); for (int sj_ = 0; sj_ < PROBE_SIDE; ++sj_) side_jobs(F, ((int)blockIdx.x - 128) * NWAVES + F.wave, 128 * NWAVES); }
        if (BOTH(2)) GRID_BAR();
    }
    if (IN(3) && F.G != 256) { REFRESH(); side_jobs(F, F.vcu * NWAVES + F.wave, F.G * NWAVES); if (BOTH(3)) GRID_BAR(); }
    if (IN(4)) REPS(4) { REFRESH(); if (rep_) GRID_BAR(); attn_phase(F, (char*)lds + RING_OFF, rep_ ? PROBE_ATT_LIMIT : 1024); if (BOTH(4)) GRID_BAR(); }
    if (IN(5)) REPS(5) { REFRESH(); if (rep_) GRID_BAR();
        pg8::Gemm g{(const pb*)F.ATT, (const pb*)F.Wt_out, M_TOK, D, D, LD8, LD8, 0, 0}; pg8::StaticOrder S; S.init(M_TOK, D, F.G, (int)blockIdx.x);
        typedef pg8::EpiResT<float, pb, false> Epi2;
        Epi2 E{F.x_prompt, F.x_sample, (pb*)F.X1, D, F.modf + 2 * D, 1.0f / (S8_W * S8_ATT), nullptr, nullptr};
        pg8::gemm_phase<Epi2, pg8::StaticOrder, true, true, 1>(F.lds + RING_OFF, g, S, E);
        if (BOTH(5)) GRID_BAR();
    }
    if (IN(6)) REPS(6) { REFRESH(); if (rep_) GRID_BAR(); norm1_phase(F); if (BOTH(6)) GRID_BAR(); }
    if (IN(7)) REPS(7) { REFRESH(); if (rep_) GRID_BAR();
        pg8::Gemm g{(const pb*)F.H, (const pb*)F.Wq, M_TOK, NPIN, D, LD8, LD8, 0, 0}; pg8::StaticOrder S; S.init(M_TOK, NPIN, F.G, (int)blockIdx.x);
        pg8::EpiI8 E{(pb*)F.QKVG, NPIN, F.sA1, F.sW};
        pg8::gemm_phase<pg8::EpiI8, pg8::StaticOrder, true, true, 2>(F.lds + RING_OFF, g, S, E);
        if (BOTH(7)) GRID_BAR();
    }
    if (IN(8)) REPS(8) { REFRESH(); if (rep_) GRID_BAR(); pool_phase(F); if (BOTH(8)) GRID_BAR(); }
    if (IN(10)) REPS(10) { REFRESH(); if (rep_) GRID_BAR();
        pg8::Gemm g{(const pb*)F.ATT, (const pb*)F.Wq2, M_TOK, D, D, LD8, LD8, 0, 0}; pg8::StaticOrder S; S.init(M_TOK, D, F.G, (int)blockIdx.x);
        typedef pg8::EpiResT<pb, pb, true> Epi5;
        Epi5 E{(const pb*)F.X1, (const pb*)F.X1 + (size_t)NCTX * D, (pb*)F.X2, D, F.modf + (size_t)NCOND * NMOD + 2 * D, 1.0f, F.sA1, F.sW2};
        pg8::gemm_phase<Epi5, pg8::StaticOrder, true, true, 2>(F.lds + RING_OFF, g, S, E);
        if (BOTH(10)) GRID_BAR();
    }
    if (IN(11)) REPS(11) { REFRESH(); if (rep_) GRID_BAR(); final_norm_phase(F); }
#undef IN
#undef REPS
#undef REFRESH
#undef BOTH
#undef GRID_BAR
}

extern "C" void kernel_launch(void* const* d_in, const int* in_sizes, int n_in, void* d_out, int out_size, void* d_ws, size_t ws_size, hipStream_t stream) {
    static int grid = 0;
    if (grid == 0) {
        if (n_in != 20 || (size_t)out_size != OUT_TOTAL || ws_size < WS_END) { fprintf(stderr, "kernel_launch: unexpected shapes: n_in %d out %d ws %zu (need %zu)\n", n_in, out_size, ws_size, (size_t)WS_END); grid = -1; return; }
        int dev = 0, cus = 0, per_cu = 0;
        if (hipGetDevice(&dev) != hipSuccess || hipDeviceGetAttribute(&cus, hipDeviceAttributeMultiprocessorCount, dev) != hipSuccess) { grid = -1; return; }
        if (hipFuncSetAttribute((const void*)fwd_kernel, hipFuncAttributeMaxDynamicSharedMemorySize, LDS_BYTES) != hipSuccess) { fprintf(stderr, "kernel_launch: hipFuncSetAttribute failed\n"); grid = -1; return; }
        if (hipOccupancyMaxActiveBlocksPerMultiprocessor(&per_cu, (const void*)fwd_kernel, NTHREADS, LDS_BYTES) != hipSuccess || per_cu < 1) fprintf(stderr, "kernel_launch: occupancy query says %d\n", per_cu);
        (void)hipGetLastError();
        grid = cus;
    }
    if (grid < 0) return;
    if (hipMemsetAsync((char*)d_ws + WS_CTL, 0, CTL_ZERO_BYTES, stream) != hipSuccess) return;
    Args a{};
    for (int i = 0; i < 20; ++i) a.in[i] = (const float*)d_in[i];
    a.out = (float*)d_out; a.ws = (unsigned char*)d_ws;
    if (N_LAUNCHES == 1) { a.ph_lo = 0; a.ph_hi = N_PHASES; hipLaunchKernelGGL(fwd_kernel, dim3(grid), dim3(NTHREADS), LDS_BYTES, stream, a); }
    else for (int p = 0; p < N_PHASES; ++p) { a.ph_lo = p; a.ph_hi = p + 1; hipLaunchKernelGGL(fwd_kernel, dim3(grid), dim3(NTHREADS), LDS_BYTES, stream, a); }
    const hipError_t le = hipPeekAtLastError();
    if (le != hipSuccess) fprintf(stderr, "kernel_launch: launch failed: %s\n", hipGetErrorName(le));
}
```

```cpp
#include <hip/hip_runtime.h>
#include <cstdio>
#include <cstdint>

#ifndef MK_N_LAUNCHES
#define MK_N_LAUNCHES 1
#endif

namespace pg8 {
#define PG8_LAS __attribute__((address_space(3)))
typedef unsigned short bf16_t;
typedef short bf16x8 __attribute__((ext_vector_type(8)));
typedef float f32x4 __attribute__((ext_vector_type(4)));
typedef unsigned u32x4 __attribute__((ext_vector_type(4)));
typedef int i32x4 __attribute__((ext_vector_type(4)));
typedef int i32x8 __attribute__((ext_vector_type(8)));
constexpr int BM = 256, BK = 64, HALF = 128, HTB = HALF * BK * 2  , STAGE_BYTES = 8 * HTB, NXCD = 8, WGM = 4;

__host__ __device__ __forceinline__ int lds_byte(int r, int c) { const int st = (r >> 4) * 2 + (c >> 5), rr = r & 15, cc = c & 31, ob = rr * 64 + cc * 2; return st * 1024 + (ob ^ (((ob >> 9) & 1) << 5)); }
__host__ __device__ __forceinline__ void stage_rc(int b, int& R, int& C) { const int st = b / 1024, sb = b % 1024, swz = sb ^ (((sb >> 9) & 1) << 5); R = (st >> 1) * 16 + swz / 64; C = (st & 1) * 32 + (swz % 64) / 2; }
__host__ __device__ __forceinline__ int perm32(int rho) { const int n = rho >> 4, i = rho & 15; return 8 * (i >> 2) + 4 * n + (i & 3); }

struct Unit { int pm, pn; };
struct Gemm { const bf16_t* A; const bf16_t* Bt; int M, N, K, lda, ldb, agrp, bgrp; };

struct StaticOrder {
    int nM, nN, nwg, G, c;
    __host__ __device__ void init(int M, int N, int G_, int c_) { nM = M / BM; nN = N / BM; nwg = nM * nN; G = G_; c = c_; }
    __host__ __device__ bool next(int i, Unit& u) const {
        const long L = (long)i * G + c; if (L >= nwg) return false;
        if (nM == 64 && (nN == 16 || nN == 32) && G % NXCD == 0) {
            const int xcd = (int)(L % NXCD), off = (int)(L / NXCD), xr = xcd >> 1, xc = xcd & 1, sg = off / (2 * nN), r = off % (2 * nN), ch = r >> 5, s = r & 31;
            u.pm = 16 * xr + 4 * sg + (s & 3); u.pn = xc * (nN >> 1) + ch * 8 + (s >> 2); return true;
        }
        int wgid = (int)L; { const int q = nwg / NXCD, r = nwg % NXCD, xcd = wgid % NXCD, off = wgid / NXCD; wgid = (xcd < r ? xcd * (q + 1) : r * (q + 1) + (xcd - r) * q) + off; }
        const int nig = WGM * nN, gid = wgid / nig, fm = gid * WGM, gsz = (nM - fm) < WGM ? (nM - fm) : WGM;
        u.pm = fm + ((wgid % nig) % gsz); u.pn = (wgid % nig) / gsz; return true;
    }
    __device__ __forceinline__ void a_ready(const Unit&) const {}
    __device__ __forceinline__ void done(const Unit&) const {}
};

struct MixedOrder {
    StaticOrder L, C; int G, c;
    __host__ __device__ void init(int G_, int c_) { G = G_; c = c_; L.init(8192, 13312, 1, 0); C.init(8192, 8192, 1, 0); }
    __host__ __device__ bool next(int i, Unit& u) const {
        int idx;
        if (G == 256) { if (i < 9) idx = i * 256 + c; else if (c < 128 && i < 12) idx = 2304 + (i - 9) * 128 + c; else return false; }
        else idx = i * G + c;
        if (idx < L.nwg) { L.next(idx, u); u.pm += 32; return true; }
        const int j = idx - L.nwg; if (j >= C.nwg) return false;
        C.next(j, u); u.pn = u.pn < 8 ? u.pn : (u.pn < 16 ? u.pn + 4 : u.pn + 20); return true;
    }
    __device__ __forceinline__ void a_ready(const Unit&) const {}
    __device__ __forceinline__ void done(const Unit&) const {}
};
__device__ __forceinline__ unsigned cvt_pk_bf16(float lo, float hi) { unsigned r; asm volatile("v_cvt_pk_bf16_f32 %0, %1, %2" : "=v"(r) : "v"(lo), "v"(hi)); return r; }
__device__ __forceinline__ float bf_lo(unsigned w) { return __uint_as_float(w << 16); }
__device__ __forceinline__ float bf_hi(unsigned w) { return __uint_as_float(w & 0xffff0000u); }
__device__ __forceinline__ float silu_f(float x) { return x * __builtin_amdgcn_rcpf(1.0f + __builtin_amdgcn_exp2f(-1.4426950408889634f * x)); }

struct EpiBf16 {
    static constexpr bool PERM = true, AFTER_DRAIN = false;
    bf16_t* O; int ldc; size_t bst; float mul;
    __device__ __forceinline__ void operator()(const f32x4 (&acc)[2][2][4][2], const Unit& u, int wr, int wc, int fr, int fq) const {
        const int row0 = u.pm * BM + wr * 64 + fr, col0 = wc * 32 + 8 * fq;
        bf16_t* Ot = O + (size_t)(2 * u.pn) * bst + col0;
#pragma unroll
        for (int ai = 0; ai < 2; ++ai)
#pragma unroll
            for (int m = 0; m < 4; ++m) { bf16_t* rowp = Ot + (size_t)(row0 + ai * HALF + m * 16) * ldc;
#pragma unroll
                for (int bj = 0; bj < 2; ++bj) { const f32x4 v0 = acc[ai][bj][m][0] * mul, v1 = acc[ai][bj][m][1] * mul;
                    u32x4 w; w.x = cvt_pk_bf16(v0[0], v0[1]); w.y = cvt_pk_bf16(v0[2], v0[3]); w.z = cvt_pk_bf16(v1[0], v1[1]); w.w = cvt_pk_bf16(v1[2], v1[3]);
                    *(u32x4*)(rowp + bj * bst) = w; } }
    }
};
constexpr int ROPE_LD = 36;
struct EpiQKVG {
    static constexpr bool PERM = true, AFTER_DRAIN = false;
    bf16_t* O; int ldc; size_t bst; float mul; const PG8_LAS float* tab;
    __device__ __forceinline__ void operator()(const f32x4 (&acc)[2][2][4][2], const Unit& u, int wr, int wc, int fr, int fq) const {
        const int row0 = u.pm * BM + wr * 64 + fr;
        if (u.pn >= 10) {
            bf16_t* Ot = O + (size_t)(2 * u.pn) * bst + wc * 32 + 8 * fq;
#pragma unroll
            for (int ai = 0; ai < 2; ++ai)
#pragma unroll
                for (int m = 0; m < 4; ++m) { bf16_t* rowp = Ot + (size_t)(row0 + ai * HALF + m * 16) * ldc;
#pragma unroll
                    for (int bj = 0; bj < 2; ++bj) { const f32x4 v0 = acc[ai][bj][m][0] * mul, v1 = acc[ai][bj][m][1] * mul;
                        u32x4 w; w.x = cvt_pk_bf16(v0[0], v0[1]); w.y = cvt_pk_bf16(v0[2], v0[3]); w.z = cvt_pk_bf16(v1[0], v1[1]); w.w = cvt_pk_bf16(v1[2], v1[3]);
                        *(u32x4*)(rowp + bj * bst) = w; } }
            return;
        }
        const bool rot = u.pm >= 32; const int blk = wc & 1, i0 = 8 * fq;
        bf16_t* Ot = O + (size_t)(2 * u.pn + (wc >> 1)) * bst + blk * 64 + i0;
        f32x4 c0 = (f32x4){mul, mul, mul, mul}, c1 = c0, s0 = (f32x4){0.f, 0.f, 0.f, 0.f}, s1 = s0;
#define PG8_ROPE_LOAD(pos) do { const PG8_LAS float* tp = tab + (pos) * ROPE_LD + i0; c0 = *(const PG8_LAS f32x4*)tp * mul; c1 = *(const PG8_LAS f32x4*)(tp + 4) * mul; \
            s0 = *(const PG8_LAS f32x4*)(tp + 64 * ROPE_LD) * mul; s1 = *(const PG8_LAS f32x4*)(tp + 64 * ROPE_LD + 4) * mul; } while (0)
#define PG8_ROPE_ROW(ai, m) do { const int row = row0 + (ai) * HALF + (m) * 16; \
            const f32x4 l0 = acc[ai][0][m][0], l1 = acc[ai][0][m][1], h0 = acc[ai][1][m][0], h1 = acc[ai][1][m][1]; \
            const f32x4 a0 = l0 * c0 - h0 * s0, a1 = l1 * c1 - h1 * s1, b0 = h0 * c0 + l0 * s0, b1 = h1 * c1 + l1 * s1; \
            u32x4 wa, wb; wa.x = cvt_pk_bf16(a0[0], a0[1]); wa.y = cvt_pk_bf16(a0[2], a0[3]); wa.z = cvt_pk_bf16(a1[0], a1[1]); wa.w = cvt_pk_bf16(a1[2], a1[3]); \
            wb.x = cvt_pk_bf16(b0[0], b0[1]); wb.y = cvt_pk_bf16(b0[2], b0[3]); wb.z = cvt_pk_bf16(b1[0], b1[1]); wb.w = cvt_pk_bf16(b1[2], b1[3]); \
            bf16_t* rowp = Ot + (size_t)row * ldc; *(u32x4*)rowp = wa; *(u32x4*)(rowp + 32) = wb; } while (0)
        if (!rot || blk == 0) {
#pragma unroll
            for (int ai = 0; ai < 2; ++ai) {
                if (rot) PG8_ROPE_LOAD(((row0 + ai * HALF) & 1023) >> 6);
#pragma unroll
                for (int m = 0; m < 4; ++m) PG8_ROPE_ROW(ai, m);
            }
        } else {
#pragma unroll
            for (int m = 0; m < 4; ++m) {
                PG8_ROPE_LOAD((row0 + m * 16) & 63);
#pragma unroll
                for (int ai = 0; ai < 2; ++ai) PG8_ROPE_ROW(ai, m);
            }
        }
#undef PG8_ROPE_LOAD
#undef PG8_ROPE_ROW
    }
};
struct EpiKV {
    static constexpr bool PERM = true, AFTER_DRAIN = false;
    bf16_t* O; int ldc; size_t bst; float* nak; float* nav; float* nbk; float* nbv;
    __device__ __forceinline__ void operator()(const f32x4 (&acc)[2][2][4][2], const Unit& u, int wr, int wc, int fr, int fq) const {
        const int pn = u.pn, colt = pn < 4 ? 2048 + 256 * pn : 5120 + 256 * (pn - 4);
        const int row0 = u.pm * BM + wr * 64 + fr, col0 = wc * 32 + 8 * fq;
        bf16_t* Ot = O + (size_t)(colt >> 7) * bst + col0;
        float* fdst; int fld;
        if (pn < 2)       { fdst = nak + pn * 256;        fld = 512; }
        else if (pn < 4)  { fdst = nav + (pn - 2) * 256;  fld = 512; }
        else if (pn < 12) { fdst = nbk + (pn - 4) * 256;  fld = 2048; }
        else              { fdst = nbv + (pn - 12) * 256; fld = 2048; }
#pragma unroll
        for (int ai = 0; ai < 2; ++ai)
#pragma unroll
            for (int m = 0; m < 4; ++m) { const int row = row0 + ai * HALF + m * 16; bf16_t* rowp = Ot + (size_t)row * ldc;
#pragma unroll
                for (int bj = 0; bj < 2; ++bj) { const f32x4 v0 = acc[ai][bj][m][0], v1 = acc[ai][bj][m][1];
                    u32x4 w; w.x = cvt_pk_bf16(v0[0], v0[1]); w.y = cvt_pk_bf16(v0[2], v0[3]); w.z = cvt_pk_bf16(v1[0], v1[1]); w.w = cvt_pk_bf16(v1[2], v1[3]);
                    *(u32x4*)(rowp + bj * bst) = w;
                    float* fp = fdst + (size_t)row * fld + wc * 32 + 8 * fq + bj * HALF; *(f32x4*)fp = v0; *(f32x4*)(fp + 4) = v1; } }
    }
};
template <class TB, class TO, bool I8> struct EpiResT {
    static constexpr bool PERM = true, AFTER_DRAIN = false;
    const TB* baseP; const TB* baseS; TO* out; int ldc; const float* gate; float mul; const float* sa; const float* sb;
    __device__ __forceinline__ void operator()(const f32x4 (&acc)[2][2][4][2], const Unit& u, int wr, int wc, int fr, int fq) const {
        const int row0 = u.pm * BM + wr * 64 + fr, col0 = u.pn * BM + wc * 32 + 8 * fq;
        const int j = u.pm < 32 ? 0 : 1 + ((u.pm - 32) >> 2);
        const float* gv = gate + (size_t)j * 12288 + col0;
        const TB* bp = u.pm < 32 ? baseP + (size_t)row0 * ldc : baseS + (size_t)(row0 - 8192) * ldc;
        f32x4 g4[2][2];
#pragma unroll
        for (int bj = 0; bj < 2; ++bj)
#pragma unroll
            for (int n = 0; n < 2; ++n) { g4[bj][n] = *(const f32x4*)(gv + bj * HALF + 4 * n); if constexpr (I8) g4[bj][n] = g4[bj][n] * *(const f32x4*)(sb + col0 + bj * HALF + 4 * n); else g4[bj][n] = g4[bj][n] * mul; }
#pragma unroll
        for (int ai = 0; ai < 2; ++ai)
#pragma unroll
            for (int m = 0; m < 4; ++m) { const size_t ro = (size_t)(ai * HALF + m * 16) * ldc + col0; TO* op = out + (size_t)row0 * ldc + ro; const TB* ip = bp + ro;
                float sr = 1.0f; if constexpr (I8) sr = sa[row0 + ai * HALF + m * 16];
#pragma unroll
                for (int bj = 0; bj < 2; ++bj) { f32x4 b0, b1;
                    if constexpr (sizeof(TB) == 4) { b0 = *(const f32x4*)(ip + bj * HALF); b1 = *(const f32x4*)(ip + bj * HALF + 4); }
                    else { const u32x4 w = *(const u32x4*)(ip + bj * HALF); b0 = (f32x4){bf_lo(w.x), bf_hi(w.x), bf_lo(w.y), bf_hi(w.y)}; b1 = (f32x4){bf_lo(w.z), bf_hi(w.z), bf_lo(w.w), bf_hi(w.w)}; }
                    f32x4 a0, a1;
                    if constexpr (I8) { a0 = __builtin_convertvector(__builtin_bit_cast(i32x4, acc[ai][bj][m][0]), f32x4) * sr; a1 = __builtin_convertvector(__builtin_bit_cast(i32x4, acc[ai][bj][m][1]), f32x4) * sr; }
                    else { a0 = acc[ai][bj][m][0]; a1 = acc[ai][bj][m][1]; }
                    const f32x4 v0 = b0 + g4[bj][0] * a0, v1 = b1 + g4[bj][1] * a1;
                    if constexpr (sizeof(TO) == 4) { *(f32x4*)(op + bj * HALF) = v0; *(f32x4*)(op + bj * HALF + 4) = v1; }
                    else { u32x4 w; w.x = cvt_pk_bf16(v0[0], v0[1]); w.y = cvt_pk_bf16(v0[2], v0[3]); w.z = cvt_pk_bf16(v1[0], v1[1]); w.w = cvt_pk_bf16(v1[2], v1[3]); *(u32x4*)(op + bj * HALF) = w; } }
                asm volatile("" ::: "memory"); }
    }
};
struct EpiPool {
    static constexpr bool PERM = true, AFTER_DRAIN = false;
    bf16_t* O; int ldc; const bf16_t* G; int ldg; const float* scale;
    __device__ __forceinline__ void operator()(const f32x4 (&acc)[2][2][4][2], const Unit& u, int wr, int wc, int fr, int fq) const {
        const int row0 = u.pm * BM + wr * 64 + fr, col0 = u.pn * BM + wc * 32 + 8 * fq;
        f32x4 sc[2][2];
#pragma unroll
        for (int bj = 0; bj < 2; ++bj)
#pragma unroll
            for (int n = 0; n < 2; ++n) sc[bj][n] = *(const f32x4*)(scale + col0 + bj * HALF + 4 * n);
#pragma unroll
        for (int ai = 0; ai < 2; ++ai)
#pragma unroll
            for (int m = 0; m < 4; ++m) { const int row = row0 + ai * HALF + m * 16; bf16_t* rowp = O + (size_t)row * ldc + col0; const bf16_t* gp = G + (size_t)row * ldg + col0;
#pragma unroll
                for (int bj = 0; bj < 2; ++bj) { const u32x4 gw = *(const u32x4*)(gp + bj * HALF);
                    f32x4 v0 = acc[ai][bj][m][0] * sc[bj][0], v1 = acc[ai][bj][m][1] * sc[bj][1];
                    v0[0] *= silu_f(bf_lo(gw.x)); v0[1] *= silu_f(bf_hi(gw.x)); v0[2] *= silu_f(bf_lo(gw.y)); v0[3] *= silu_f(bf_hi(gw.y));
                    v1[0] *= silu_f(bf_lo(gw.z)); v1[1] *= silu_f(bf_hi(gw.z)); v1[2] *= silu_f(bf_lo(gw.w)); v1[3] *= silu_f(bf_hi(gw.w));
                    u32x4 w; w.x = cvt_pk_bf16(v0[0], v0[1]); w.y = cvt_pk_bf16(v0[2], v0[3]); w.z = cvt_pk_bf16(v1[0], v1[1]); w.w = cvt_pk_bf16(v1[2], v1[3]);
                    *(u32x4*)(rowp + bj * HALF) = w; }
                asm volatile("" ::: "memory"); }
    }
};
struct EpiI8 {
    static constexpr bool PERM = true, AFTER_DRAIN = false;
    bf16_t* O; int ldc; const float* sa; const float* sb;
    __device__ __forceinline__ void operator()(const f32x4 (&acc)[2][2][4][2], const Unit& u, int wr, int wc, int fr, int fq) const {
        const int row0 = u.pm * BM + wr * 64 + fr, col0 = u.pn * BM + wc * 32 + 8 * fq;
        f32x4 sc[2][2];
#pragma unroll
        for (int bj = 0; bj < 2; ++bj)
#pragma unroll
            for (int n = 0; n < 2; ++n) sc[bj][n] = *(const f32x4*)(sb + col0 + bj * HALF + 4 * n);
#pragma unroll
        for (int ai = 0; ai < 2; ++ai)
#pragma unroll
            for (int m = 0; m < 4; ++m) { const int row = row0 + ai * HALF + m * 16; const float sr = sa[row]; bf16_t* rowp = O + (size_t)row * ldc + col0;
#pragma unroll
                for (int bj = 0; bj < 2; ++bj) { const i32x4 i0 = __builtin_bit_cast(i32x4, acc[ai][bj][m][0]), i1 = __builtin_bit_cast(i32x4, acc[ai][bj][m][1]);
                    const f32x4 v0 = __builtin_convertvector(i0, f32x4) * sc[bj][0] * sr, v1 = __builtin_convertvector(i1, f32x4) * sc[bj][1] * sr;
                    u32x4 w; w.x = cvt_pk_bf16(v0[0], v0[1]); w.y = cvt_pk_bf16(v0[2], v0[3]); w.z = cvt_pk_bf16(v1[0], v1[1]); w.w = cvt_pk_bf16(v1[2], v1[3]);
                    *(u32x4*)(rowp + bj * HALF) = w; } }
    }
};
template <class Epi, class Sched, bool ALIGN_EPI = false, bool SP2 = false, int MODE = 0>
__device__ __forceinline__ void gemm_phase(PG8_LAS unsigned char* lds, const Gemm g, const Sched& S, const Epi& E) {
    const int tid = threadIdx.x, wid = __builtin_amdgcn_readfirstlane(tid >> 6), lane = tid & 63, wr = wid >> 2, wc = wid & 3, fr = lane & 15, fq = lane >> 4;
    constexpr bool F8 = MODE == 1, I8 = MODE == 2; constexpr int ES = MODE ? 1 : 2; const int K = g.K, nt = K * ES / (BK * 2);
    unsigned voffA[2], voffB[2];
#pragma unroll
    for (int i = 0; i < 2; ++i) { int R, C; stage_rc(tid * 16 + i * 8192, R, C); const int Rb = Epi::PERM ? ((R & ~31) + perm32(R & 31)) : R;
        voffA[i] = (unsigned)(R * g.lda * ES + C * 2); voffB[i] = (unsigned)(Rb * g.ldb * ES + C * 2); }
    const size_t kstep = (size_t)(BK * 2);
    const size_t hstepA = (size_t)HALF * g.lda * ES, hstepB = (size_t)HALF * g.ldb * ES;
    const size_t tstepA = 2 * hstepA, tstepB = 2 * hstepB;
    const unsigned ldsw = (unsigned)wid * 1024u;
    const int aoff = lds_byte(wr * 64 + fr, fq * 8), boff = lds_byte(wc * 32 + fr, fq * 8);
#define PG8_SA(b, h) (((b) * 2 + (h)) * HTB)
#define PG8_SB(b, h) ((4 + (b) * 2 + (h)) * HTB)
#define PG8_STAGE(bufoff, gbase, voff) do { _Pragma("unroll") for (int _i = 0; _i < 2; ++_i) \
        __builtin_amdgcn_global_load_lds((const unsigned*)((const char*)(gbase) + (voff)[_i]), (PG8_LAS unsigned*)(lds + (bufoff) + ldsw + _i * 8192), 16, 0, 0); } while (0)
#define PG8_LDA(dst, b, h) do { _Pragma("unroll") for (int m = 0; m < 4; ++m) { if constexpr (F8) dst##8[m] = PG8_CAT(*(const PG8_LAS bf16x8*)(lds + PG8_SA(b, h) + aoff + m * 2048), *(const PG8_LAS bf16x8*)(lds + PG8_SA(b, h) + aoff + m * 2048 + 1024)); \
        else { _Pragma("unroll") for (int k = 0; k < 2; ++k) dst[m][k] = *(const PG8_LAS bf16x8*)(lds + PG8_SA(b, h) + aoff + m * 2048 + k * 1024); } } } while (0)
#define PG8_LDB(dst, b, h) do { _Pragma("unroll") for (int n = 0; n < 2; ++n) { if constexpr (F8) dst##8[n] = PG8_CAT(*(const PG8_LAS bf16x8*)(lds + PG8_SB(b, h) + boff + n * 2048), *(const PG8_LAS bf16x8*)(lds + PG8_SB(b, h) + boff + n * 2048 + 1024)); \
        else { _Pragma("unroll") for (int k = 0; k < 2; ++k) dst[n][k] = *(const PG8_LAS bf16x8*)(lds + PG8_SB(b, h) + boff + n * 2048 + k * 1024); } } } while (0)
#define PG8_MMA(ai, bj, At, Bt) do { __builtin_amdgcn_s_setprio(1); _Pragma("unroll") for (int m = 0; m < 4; ++m) _Pragma("unroll") for (int n = 0; n < 2; ++n) { \
        if constexpr (F8) asm volatile("v_mfma_scale_f32_16x16x128_f8f6f4 %0, %1, %2, %0, %3, %3 op_sel_hi:[0,0,0]" : "+v"(acc[ai][bj][m][n]) : "v"(Bt##8[n]), "v"(At##8[m]), "v"(sc1)); \
        else if constexpr (I8) { _Pragma("unroll") for (int k = 0; k < 2; ++k) acc[ai][bj][m][n] = __builtin_bit_cast(f32x4, __builtin_amdgcn_mfma_i32_16x16x64_i8(__builtin_bit_cast(i32x4, Bt[n][k]), __builtin_bit_cast(i32x4, At[m][k]), __builtin_bit_cast(i32x4, acc[ai][bj][m][n]), 0, 0, 0)); } \
        else { _Pragma("unroll") for (int k = 0; k < 2; ++k) acc[ai][bj][m][n] = __builtin_amdgcn_mfma_f32_16x16x32_bf16(Bt[n][k], At[m][k], acc[ai][bj][m][n], 0, 0, 0); } } \
        __builtin_amdgcn_s_setprio(0); } while (0)
#define PG8_CAT(lo, hi) __builtin_shufflevector(__builtin_bit_cast(i32x4, lo), __builtin_bit_cast(i32x4, hi), 0, 1, 2, 3, 4, 5, 6, 7)
#define PG8_WAIT_V(n) asm volatile("s_waitcnt vmcnt(" #n ")" ::: "memory")
#define PG8_WAIT_L(n) asm volatile("s_waitcnt lgkmcnt(" #n ")" ::: "memory")
#define PG8_BAR __builtin_amdgcn_s_barrier()
#define PG8_SCHED __builtin_amdgcn_sched_barrier(0)
    Unit cur, nxt; int ui = 0;
    if (!S.next(0, cur)) return;
    f32x4 acc[2][2][4][2];
#pragma unroll
    for (int a = 0; a < 2; ++a)
#pragma unroll
        for (int b = 0; b < 2; ++b)
#pragma unroll
            for (int m = 0; m < 4; ++m)
#pragma unroll
                for (int n = 0; n < 2; ++n) acc[a][b][m][n] = (f32x4){0.f, 0.f, 0.f, 0.f};
    int sc1 = 0x7F7F7F7F; asm volatile("" : "+v"(sc1));
    bf16x8 At[4][2], B0[2][2], B1[2][2]; i32x8 At8[4], B08[2], B18[2];
    const char* cA = (const char*)g.A + (size_t)cur.pm * tstepA + (g.agrp ? (size_t)(cur.pn / g.agrp) * K * ES : (size_t)0); const char* cB = (const char*)g.Bt + (size_t)cur.pn * tstepB + (g.bgrp ? (size_t)(cur.pm / g.bgrp) * K * ES : (size_t)0);
    S.a_ready(cur);
    if constexpr (SP2) {
        PG8_STAGE(PG8_SB(0, 0), cB, voffB); PG8_STAGE(PG8_SB(0, 1), cB + hstepB, voffB); PG8_STAGE(PG8_SA(0, 0), cA, voffA); PG8_STAGE(PG8_SA(0, 1), cA + hstepA, voffA);
        if (wr == 1) PG8_BAR;
        PG8_WAIT_V(2); PG8_BAR;
        PG8_STAGE(PG8_SB(1, 0), cB + kstep, voffB); PG8_STAGE(PG8_SA(1, 0), cA + kstep, voffA); PG8_STAGE(PG8_SB(1, 1), cB + hstepB + kstep, voffB);
        PG8_WAIT_V(6); PG8_BAR;
    } else {
        PG8_STAGE(PG8_SB(0, 0), cB, voffB); PG8_STAGE(PG8_SA(0, 0), cA, voffA); PG8_STAGE(PG8_SB(0, 1), cB + hstepB, voffB); PG8_STAGE(PG8_SA(0, 1), cA + hstepA, voffA);
        if (wr == 1) PG8_BAR;
        PG8_WAIT_V(4); PG8_BAR;
        PG8_STAGE(PG8_SB(1, 0), cB + kstep, voffB); PG8_STAGE(PG8_SA(1, 0), cA + kstep, voffA); PG8_STAGE(PG8_SB(1, 1), cB + hstepB + kstep, voffB);
        PG8_WAIT_V(6); PG8_BAR;
    }
    for (;;) {
        const bool has_next = S.next(ui + 1, nxt);
        const char* nA = has_next ? (const char*)g.A + (size_t)nxt.pm * tstepA + (g.agrp ? (size_t)(nxt.pn / g.agrp) * K * ES : (size_t)0) : cA; const char* nB = has_next ? (const char*)g.Bt + (size_t)nxt.pn * tstepB + (g.bgrp ? (size_t)(nxt.pm / g.bgrp) * K * ES : (size_t)0) : cB;
        for (int t = 0; t < nt; t += 2) {
            const bool last = (t == nt - 2);
            const char* a1 = cA + (size_t)(t + 1) * kstep;
            const char* a2 = last ? nA : cA + (size_t)(t + 2) * kstep; const char* b2 = last ? nB : cB + (size_t)(t + 2) * kstep;
            const char* a3 = a2 + kstep; const char* b3 = b2 + kstep;
            if (last && has_next) S.a_ready(nxt);
            if constexpr (SP2) {
            PG8_LDB(B0, 0, 0); PG8_LDB(B1, 0, 1); PG8_SCHED; PG8_LDA(At, 0, 0); PG8_STAGE(PG8_SA(1, 1), a1 + hstepA, voffA);
            PG8_WAIT_V(8); PG8_WAIT_L(0); PG8_BAR; PG8_MMA(0, 0, At, B0); PG8_MMA(0, 1, At, B1); PG8_BAR; PG8_SCHED;
            PG8_LDA(At, 0, 1); PG8_STAGE(PG8_SB(0, 0), b2, voffB); PG8_STAGE(PG8_SB(0, 1), b2 + hstepB, voffB); PG8_STAGE(PG8_SA(0, 0), a2, voffA);
            PG8_WAIT_V(8); PG8_WAIT_L(0); PG8_BAR; PG8_MMA(1, 0, At, B0); PG8_MMA(1, 1, At, B1); PG8_BAR; PG8_SCHED;
            PG8_LDB(B0, 1, 0); PG8_LDB(B1, 1, 1); PG8_SCHED; PG8_LDA(At, 1, 0); PG8_STAGE(PG8_SA(0, 1), a2 + hstepA, voffA);
            PG8_WAIT_V(8); PG8_WAIT_L(0); PG8_BAR; PG8_MMA(0, 0, At, B0); PG8_MMA(0, 1, At, B1); PG8_BAR; PG8_SCHED;
            PG8_LDA(At, 1, 1); PG8_STAGE(PG8_SB(1, 0), b3, voffB); PG8_STAGE(PG8_SB(1, 1), b3 + hstepB, voffB); PG8_STAGE(PG8_SA(1, 0), a3, voffA);
            PG8_WAIT_V(8); PG8_WAIT_L(0); PG8_BAR; PG8_MMA(1, 0, At, B0); PG8_MMA(1, 1, At, B1); PG8_BAR; PG8_SCHED;
            } else {
            PG8_LDB(B0, 0, 0); PG8_SCHED; PG8_LDA(At, 0, 0); PG8_STAGE(PG8_SA(1, 1), a1 + hstepA, voffA);
            PG8_WAIT_L(8); PG8_BAR; PG8_WAIT_L(0); PG8_MMA(0, 0, At, B0); PG8_BAR; PG8_SCHED;
            PG8_LDB(B1, 0, 1); PG8_STAGE(PG8_SB(0, 0), b2, voffB);
            PG8_BAR; PG8_WAIT_L(0); PG8_MMA(0, 1, At, B1); PG8_BAR;
            PG8_LDA(At, 0, 1); PG8_STAGE(PG8_SA(0, 0), a2, voffA);
            PG8_BAR; PG8_WAIT_L(0); PG8_MMA(1, 0, At, B0); PG8_BAR; PG8_SCHED;
            PG8_STAGE(PG8_SB(0, 1), b2 + hstepB, voffB);
            PG8_WAIT_V(6); PG8_BAR; PG8_MMA(1, 1, At, B1); PG8_BAR;
            PG8_LDB(B0, 1, 0); PG8_SCHED; PG8_LDA(At, 1, 0); PG8_STAGE(PG8_SA(0, 1), a2 + hstepA, voffA);
            PG8_WAIT_L(8); PG8_BAR; PG8_WAIT_L(0); PG8_MMA(0, 0, At, B0); PG8_BAR; PG8_SCHED;
            PG8_LDB(B1, 1, 1); PG8_STAGE(PG8_SB(1, 0), b3, voffB);
            PG8_BAR; PG8_WAIT_L(0); PG8_MMA(0, 1, At, B1); PG8_BAR;
            PG8_LDA(At, 1, 1); PG8_STAGE(PG8_SA(1, 0), a3, voffA);
            PG8_BAR; PG8_WAIT_L(0); PG8_MMA(1, 0, At, B0); PG8_BAR; PG8_SCHED;
            PG8_STAGE(PG8_SB(1, 1), b3 + hstepB, voffB);
            PG8_WAIT_V(6); PG8_BAR; PG8_MMA(1, 1, At, B1); PG8_BAR;
            }
        }
        if constexpr (ALIGN_EPI) { if (wr == 0) PG8_BAR; }
        if constexpr (F8) asm volatile("s_nop 15\n\ts_nop 15" ::: "memory");
        if constexpr (!Epi::AFTER_DRAIN) { E(acc, cur, wr, wc, fr, fq); S.done(cur); }
        if (!has_next) break;
#pragma unroll
        for (int a = 0; a < 2; ++a)
#pragma unroll
            for (int b = 0; b < 2; ++b)
#pragma unroll
                for (int m = 0; m < 4; ++m)
#pragma unroll
                    for (int n = 0; n < 2; ++n) acc[a][b][m][n] = (f32x4){0.f, 0.f, 0.f, 0.f};
        cur = nxt; cA = nA; cB = nB; ++ui;
        if constexpr (ALIGN_EPI) { if (wr == 1) PG8_BAR; }
    }
    PG8_WAIT_V(0);
    if constexpr (!ALIGN_EPI) { if (wr == 0) PG8_BAR; }
    PG8_BAR;
    if constexpr (Epi::AFTER_DRAIN) { E.fused(acc, cur, wr, wc, fr, fq, lds, wid, lane); S.done(cur); }
#undef PG8_SA
#undef PG8_SB
#undef PG8_STAGE
#undef PG8_LDA
#undef PG8_LDB
#undef PG8_MMA
#undef PG8_CAT
#undef PG8_WAIT_V
#undef PG8_WAIT_L
#undef PG8_BAR
#undef PG8_SCHED
}
}

namespace att {
typedef unsigned short bf16;
using bf16x8 = __attribute__((ext_vector_type(8))) short;
using s16x4  = __attribute__((ext_vector_type(4))) short;
using f32x16 = __attribute__((ext_vector_type(16))) float;
using u32x4  = __attribute__((ext_vector_type(4))) unsigned;
constexpr int HD_ = 128, NW = 8, QBLK = 32, KVBLK = 64, LDQ = 128  , LDO = 4096 + 128;
constexpr float SCALE = 0.088388347648318440f, INV_SCALE = 11.313708498984761f, THR = 8.f, NEG = -1e30f;
constexpr size_t SHM_V = KVBLK * HD_ * 2, SHM_K = KVBLK * HD_ * 2, OFF_WS = 2 * SHM_V + 2 * SHM_K, OFF_RPB = OFF_WS + NW * 64 * 4, OFF_STG = OFF_RPB + 3072, OFF_SINK = OFF_STG + NW * 32 * 272, SHM_ATTN = OFF_SINK + 64;
constexpr int STG_ROW = 272, STG_WAVE = 32 * STG_ROW;
#define KSWZ(row, colB) ((row) * 256 + ((colB) ^ (((row) & 7) << 4)))
#define SBAR() __builtin_amdgcn_sched_barrier(0)
__device__ __forceinline__ int crow(int r, int hi) { return (r & 3) + 8 * (r >> 2) + 4 * hi; }
__device__ __forceinline__ unsigned cvtpk(float lo, float hi) { unsigned r; asm volatile("v_cvt_pk_bf16_f32 %0, %1, %2" : "=v"(r) : "v"(lo), "v"(hi)); return r; }

struct Unit {
    const bf16* q;
    const bf16* kc; const bf16* vc; int nctx;
    const bf16* kl; const bf16* vl;
    int nt;
    int mask;
    int qpos0, kpos0;
    int has_sink, sink_i;
    const float* rpb;
    const bf16* gate; unsigned char* out;
};

__device__ __forceinline__ void partialSM(f32x16& p0, f32x16& p1, float& m_reg, float& mn, float& alpha) {
    constexpr float C = SCALE * 1.4426950408889634f;
    float pmax = p0[0];
#pragma unroll
    for (int r = 1; r < 16; ++r) pmax = fmaxf(pmax, p0[r]);
#pragma unroll
    for (int r = 0; r < 16; ++r) pmax = fmaxf(pmax, p1[r]);
    { auto rr = __builtin_amdgcn_permlane32_swap(__float_as_uint(pmax), __float_as_uint(pmax), false, false);
      pmax = fmaxf(__uint_as_float(rr[0]), __uint_as_float(rr[1])); }
    if (__builtin_expect(__all(pmax - m_reg <= THR / SCALE), 1)) { mn = m_reg; alpha = 1.f; }
    else { mn = fmaxf(m_reg, pmax); alpha = __builtin_amdgcn_exp2f((m_reg - mn) * C); m_reg = mn; }
    const float mnC = -mn * C;
#pragma unroll
    for (int r = 0; r < 16; ++r) p0[r] = fmaf(p0[r], C, mnC);
#pragma unroll
    for (int r = 0; r < 16; ++r) p1[r] = fmaf(p1[r], C, mnC);
#pragma unroll
    for (int r = 0; r < 16; ++r) p0[r] = __builtin_amdgcn_exp2f(p0[r]);
}
__device__ __forceinline__ void finishSM(f32x16& p0, f32x16& p1, float alpha, float& l_reg, bf16x8& pa0, bf16x8& pa1, bf16x8& pa2, bf16x8& pa3) {
#pragma unroll
    for (int r = 0; r < 16; ++r) p1[r] = __builtin_amdgcn_exp2f(p1[r]);
    float ps = 0;
#pragma unroll
    for (int r = 0; r < 16; ++r) ps += p0[r];
#pragma unroll
    for (int r = 0; r < 16; ++r) ps += p1[r];
    { auto rr = __builtin_amdgcn_permlane32_swap(__float_as_uint(ps), __float_as_uint(ps), false, false);
      ps = __uint_as_float(rr[0]) + __uint_as_float(rr[1]); }
    l_reg = l_reg * alpha + ps;
#define ATT_PK4(P, BASE, OUT) do { unsigned a0 = cvtpk(P[BASE + 0], P[BASE + 1]), a1 = cvtpk(P[BASE + 2], P[BASE + 3]);   \
    unsigned b0 = cvtpk(P[BASE + 4], P[BASE + 5]), b1 = cvtpk(P[BASE + 6], P[BASE + 7]);                              \
    auto r0 = __builtin_amdgcn_permlane32_swap(a0, b0, false, false); auto r1 = __builtin_amdgcn_permlane32_swap(a1, b1, false, false); \
    u32x4 w = {r0[0], r1[0], r0[1], r1[1]}; OUT = *reinterpret_cast<bf16x8*>(&w); } while (0)
    ATT_PK4(p0, 0, pa0); ATT_PK4(p0, 8, pa1); ATT_PK4(p1, 0, pa2); ATT_PK4(p1, 8, pa3);
#undef ATT_PK4
}
__device__ __forceinline__ void qkt(f32x16& p0, f32x16& p1, const char* Ks, const bf16x8* qr, int r32, int hi) {
    p0 = f32x16{}; p1 = f32x16{};
#pragma unroll
    for (int d0 = 0; d0 < 8; ++d0) { const int cb = (d0 * 16 + hi * 8) * 2;
        const bf16x8 b0 = *reinterpret_cast<const bf16x8*>(Ks + KSWZ(r32, cb));
        const bf16x8 b1 = *reinterpret_cast<const bf16x8*>(Ks + KSWZ(32 + r32, cb));
        p0 = __builtin_amdgcn_mfma_f32_32x32x16_bf16(b0, qr[d0], p0, 0, 0, 0);
        p1 = __builtin_amdgcn_mfma_f32_32x32x16_bf16(b1, qr[d0], p1, 0, 0, 0); }
}
__device__ __forceinline__ int v_st(int k, int c) { const int kk = (k & ~0xC) | ((k & 4) << 1) | ((k & 8) >> 1); return ((kk >> 3) * 4 + (c >> 5)) * 512 + ((kk & 7) * 32 + (c & 31)) * 2; }
__device__ __forceinline__ int v_rd_base(int lane) { return ((lane & 3) << 3) | (((lane >> 2) & 3) << 6) | (((lane >> 4) & 1) << 5) | (((lane >> 5) & 1) << 8); }
constexpr int v_rd_off(int d0, int ks, int half) { return d0 * 512 + ks * 4096 + half * 2048; }
template <int OFF> __device__ __forceinline__ s16x4 tr_read(int vb) {
    s16x4 r; asm volatile("ds_read_b64_tr_b16 %0, %1 offset:%2" : "=&v"(r) : "v"(vb), "i"(OFF) : "memory"); return r;
}
template <int D0> __device__ __forceinline__ void pv_one(f32x16& od, int vb, bf16x8 pa0, bf16x8 pa1, bf16x8 pa2, bf16x8 pa3) {
    const s16x4 l0 = tr_read<v_rd_off(D0, 0, 0)>(vb), h0 = tr_read<v_rd_off(D0, 0, 1)>(vb), l1 = tr_read<v_rd_off(D0, 1, 0)>(vb), h1 = tr_read<v_rd_off(D0, 1, 1)>(vb);
    const s16x4 l2 = tr_read<v_rd_off(D0, 2, 0)>(vb), h2 = tr_read<v_rd_off(D0, 2, 1)>(vb), l3 = tr_read<v_rd_off(D0, 3, 0)>(vb), h3 = tr_read<v_rd_off(D0, 3, 1)>(vb);
    asm volatile("s_waitcnt lgkmcnt(0)" ::: "memory"); SBAR();
#define ATT_PK(L, H) (bf16x8){L[0], L[1], L[2], L[3], H[0], H[1], H[2], H[3]}
    od = __builtin_amdgcn_mfma_f32_32x32x16_bf16(pa0, ATT_PK(l0, h0), od, 0, 0, 0);
    od = __builtin_amdgcn_mfma_f32_32x32x16_bf16(pa1, ATT_PK(l1, h1), od, 0, 0, 0);
    od = __builtin_amdgcn_mfma_f32_32x32x16_bf16(pa2, ATT_PK(l2, h2), od, 0, 0, 0);
    od = __builtin_amdgcn_mfma_f32_32x32x16_bf16(pa3, ATT_PK(l3, h3), od, 0, 0, 0);
#undef ATT_PK
}
__device__ __forceinline__ void pv_d0(f32x16* o, int vb, bf16x8 pa0, bf16x8 pa1, bf16x8 pa2, bf16x8 pa3) {
    pv_one<0>(o[0], vb, pa0, pa1, pa2, pa3); pv_one<1>(o[1], vb, pa0, pa1, pa2, pa3); pv_one<2>(o[2], vb, pa0, pa1, pa2, pa3); pv_one<3>(o[3], vb, pa0, pa1, pa2, pa3);
}
__device__ __forceinline__ void apply_mask(f32x16& p0, f32x16& p1, const Unit& u, int j, int wid, int r32, int hi, const float* rpb_l) {
    if (u.mask == 0 || j < u.nctx) return;
    const int jl = j - u.nctx;
    asm volatile("" : "+v"(r32), "+v"(hi));
    if (u.mask == 1) {
        const int qw0 = u.qpos0 + wid * QBLK, k0 = u.kpos0 + jl * KVBLK;
        if (qw0 + 31 - k0 <= 128 && k0 + 63 - qw0 <= 128) return;
        if (qw0 - (k0 + 63) > 128 || k0 - (qw0 + 31) > 128) {
#pragma unroll
            for (int r = 0; r < 16; ++r) { p0[r] = NEG; p1[r] = NEG; }
            return; }
        const int dl = qw0 + r32 - k0 - 4 * hi + 128;
#pragma unroll
        for (int r = 0; r < 16; ++r) { const int kc0 = (r & 3) + 8 * (r >> 2);
            p0[r] = (unsigned)(dl - kc0) > 256u ? NEG : p0[r]; p1[r] = (unsigned)(dl - kc0 - 32) > 256u ? NEG : p1[r]; }
    } else {
        const int rq = u.qpos0 + (wid >> 1), kr = u.kpos0 + jl;
        const int rs = rq - 4 < 0 ? 0 : (rq - 4 > 8 ? 8 : rq - 4);
        if (kr < rs || kr >= rs + 8) {
#pragma unroll
            for (int r = 0; r < 16; ++r) { p0[r] = NEG; p1[r] = NEG; }
            return; }
        const int c = (wid & 1) * 32 + r32, cs = c - 8 < 0 ? 0 : (c - 8 > 48 ? 48 : c - 8);
        const int lv = 4 * hi - cs;
        const float* tb = rpb_l + (kr - rq + 7) * 31 + (4 * hi - c + 15);
#pragma unroll
        for (int rg = 0; rg < 16; rg += 4) {
            float b0[4], b1[4];
#pragma unroll
            for (int e = 0; e < 4; ++e) { const int kc0 = ((rg + e) & 3) + 8 * ((rg + e) >> 2); b0[e] = tb[kc0]; b1[e] = tb[kc0 + 32]; }
#pragma unroll
            for (int e = 0; e < 4; ++e) { const int r = rg + e, kc0 = (r & 3) + 8 * (r >> 2);
                p0[r] = (unsigned)(kc0 + lv) < 16u ? p0[r] + b0[e] : NEG; p1[r] = (unsigned)(kc0 + 32 + lv) < 16u ? p1[r] + b1[e] : NEG; }
        }
    }
}

struct Regs { bf16x8 qr[8]; bf16x8 vs0[2], vs1[2], ks0[2], ks1[2]; float rpbv; u32x4 w[4]; unsigned char* wp; };
__device__ __forceinline__ void attn_flush(Regs& R) {
#pragma unroll
    for (int i = 0; i < 4; ++i) *reinterpret_cast<u32x4*>(R.wp + (size_t)i * 8 * LDO) = R.w[i];
}
template <int I> __device__ __forceinline__ void sload(const Unit& u, Regs& R, int j, int sr, int sc) {
    const bf16* kt_; const bf16* vt_; constexpr int ld_ = LDQ;
    if (j < u.nctx) { kt_ = u.kc + (size_t)j * KVBLK * LDQ; vt_ = u.vc + (size_t)j * KVBLK * LDQ; }
    else { kt_ = u.kl + (size_t)(j - u.nctx) * KVBLK * LDQ; vt_ = u.vl + (size_t)(j - u.nctx) * KVBLK * LDQ; }
    R.vs0[I] = *reinterpret_cast<const bf16x8*>(vt_ + (size_t)sr * ld_ + sc); R.vs1[I] = *reinterpret_cast<const bf16x8*>(vt_ + (size_t)(32 + sr) * ld_ + sc);
    R.ks0[I] = *reinterpret_cast<const bf16x8*>(kt_ + (size_t)sr * ld_ + sc); R.ks1[I] = *reinterpret_cast<const bf16x8*>(kt_ + (size_t)(32 + sr) * ld_ + sc);
}
__device__ __forceinline__ void attn_prefetch(const Unit& u, Regs& R) {
    int tid = threadIdx.x; asm volatile("" : "+v"(tid));
    const int wid = __builtin_amdgcn_readfirstlane(tid >> 6), lane = tid & 63, r32 = lane & 31, hi = lane >> 5, sr = tid >> 4, sc = (tid & 15) * 8;
    const bf16* Qw = u.q + (size_t)(wid * QBLK + r32) * LDQ + hi * 8;
#pragma unroll
    for (int d0 = 0; d0 < 8; ++d0) R.qr[d0] = *reinterpret_cast<const bf16x8*>(Qw + d0 * 16);
    sload<0>(u, R, 0, sr, sc); sload<1>(u, R, 1, sr, sc);
    R.rpbv = u.rpb[tid < 15 * 31 ? tid : 0];
}
__device__ __forceinline__ void attn_unit(const Unit& u, bool has_next, const Unit& nu, Regs& R, char* lds, bool has_prev) {
    int tid = threadIdx.x; asm volatile("" : "+v"(tid));
    const int wid = __builtin_amdgcn_readfirstlane(tid >> 6), lane = tid & 63, r32 = lane & 31, hi = lane >> 5;
    char* V_lds = lds; char* K_lds = lds + 2 * SHM_V;
    float* ws = (float*)(lds + OFF_WS) + wid * 64; float* li_l = ws; float* al_l = ws + 32;
    float* rpb_l = (float*)(lds + OFF_RPB + 256);
    if (u.mask == 2) { if (tid < 15 * 31) rpb_l[tid] = R.rpbv * INV_SCALE; }
    float m_reg = NEG, l_reg = 0; f32x16 o[4] = {};
    const int sr = tid >> 4, sc = (tid & 15) * 8, vst0 = v_st(sr, sc), vst1 = v_st(32 + sr, sc);
    const int vb0 = (int)(uintptr_t)V_lds + v_rd_base(lane);
#define ATT_SLOAD(i, j) sload<i>(u, R, (j), sr, sc)
#define ATT_SWRITE(b, i) do { *(bf16x8*)(V_lds + (b) * SHM_V + vst0) = R.vs0[i]; *(bf16x8*)(V_lds + (b) * SHM_V + vst1) = R.vs1[i]; const int kc_ = sc * 2;  \
    *(bf16x8*)(K_lds + (b) * SHM_K + KSWZ(sr, kc_)) = R.ks0[i]; *(bf16x8*)(K_lds + (b) * SHM_K + KSWZ(32 + sr, kc_)) = R.ks1[i]; } while (0)
#define ATT_SWAIT() asm volatile("s_waitcnt vmcnt(4)" ::: "memory")
#define ATT_RESC(a) do { if (__any((a) < 1.f)) { if (hi == 0) al_l[r32] = (a); asm volatile("s_waitcnt lgkmcnt(0)" ::: "memory"); \
    _Pragma("unroll") for (int d = 0; d < 4; ++d) _Pragma("unroll") for (int r = 0; r < 16; ++r) o[d][r] *= al_l[crow(r, hi)]; } } while (0)
    f32x16 pA0, pA1, pB0, pB1; float mnA, mnB, alA, alB; bf16x8 pa0, pa1, pa2, pa3; const int NT = u.nt;
    constexpr int SE = 0, SO = 1;
    ATT_SWRITE(0, SE);
    {
        const unsigned gl = (unsigned)(uintptr_t)(lds + OFF_STG) + (unsigned)wid * (unsigned)STG_WAVE;
#pragma unroll
        for (int t = 0; t < 8; ++t) { const int rr = 4 * t + (lane >> 4), c = (lane & 15) ^ (rr & 15); const unsigned voff = (unsigned)(((wid * QBLK + rr) * LDQ + c * 8) * 2);
            asm volatile("s_mov_b32 m0, %0\n\ts_nop 0\n\tglobal_load_lds_dwordx4 %1, %2" :: "s"(gl + t * 1024), "v"(voff), "s"(u.gate) : "memory"); }
    }
    ATT_SLOAD(SE, 2);
    if (has_prev) attn_flush(R);
    __syncthreads();
    qkt(pA0, pA1, K_lds, R.qr, r32, hi); apply_mask(pA0, pA1, u, 0, wid, r32, hi, rpb_l); partialSM(pA0, pA1, m_reg, mnA, alA);
    ATT_SWRITE(1, SO); __syncthreads();
    for (int j = 1; j + 1 < NT; j += 2) {
        SBAR(); qkt(pB0, pB1, K_lds + SHM_K, R.qr, r32, hi);
        finishSM(pA0, pA1, alA, l_reg, pa0, pa1, pa2, pa3); SBAR();
        ATT_SLOAD(SO, j + 2); SBAR();
        pv_d0(o, vb0, pa0, pa1, pa2, pa3); apply_mask(pB0, pB1, u, j, wid, r32, hi, rpb_l); partialSM(pB0, pB1, m_reg, mnB, alB);
        __syncthreads(); ATT_SWAIT(); ATT_SWRITE(0, SE);
        ATT_RESC(alB); __syncthreads();
        SBAR(); qkt(pA0, pA1, K_lds, R.qr, r32, hi);
        finishSM(pB0, pB1, alB, l_reg, pa0, pa1, pa2, pa3); SBAR();
        ATT_SLOAD(SE, j + 3 < NT ? j + 3 : NT - 1); SBAR();
        pv_d0(o, vb0 + (int)SHM_V, pa0, pa1, pa2, pa3); apply_mask(pA0, pA1, u, j + 1, wid, r32, hi, rpb_l); partialSM(pA0, pA1, m_reg, mnA, alA);
        __syncthreads(); ATT_SWAIT(); ATT_SWRITE(1, SO);
        ATT_RESC(alA); __syncthreads();
    }
    SBAR(); qkt(pB0, pB1, K_lds + SHM_K, R.qr, r32, hi);
    finishSM(pA0, pA1, alA, l_reg, pa0, pa1, pa2, pa3); SBAR();
    if (has_next) attn_prefetch(nu, R);
    SBAR();
    pv_d0(o, vb0, pa0, pa1, pa2, pa3); apply_mask(pB0, pB1, u, NT - 1, wid, r32, hi, rpb_l); partialSM(pB0, pB1, m_reg, mnB, alB);
    __syncthreads(); ATT_RESC(alB);
    finishSM(pB0, pB1, alB, l_reg, pa0, pa1, pa2, pa3); SBAR();
    u32x4 gA[4], gB[4];
    { const char* gs_ = lds + OFF_STG + wid * STG_WAVE;
#pragma unroll
      for (int i = 0; i < 4; ++i) { const int id = i * 64 + lane, row = id >> 3, ch = (id & 7) * 2;
          gA[i] = *reinterpret_cast<const u32x4*>(gs_ + row * 256 + ((ch ^ (row & 15)) << 4)); gB[i] = *reinterpret_cast<const u32x4*>(gs_ + row * 256 + (((ch + 1) ^ (row & 15)) << 4)); } }
    SBAR();
    pv_d0(o, vb0 + (int)SHM_V, pa0, pa1, pa2, pa3);
    if (u.has_sink) l_reg += __builtin_amdgcn_exp2f(((const float*)(lds + OFF_SINK))[u.sink_i] * 1.4426950408889634f - m_reg * (SCALE * 1.4426950408889634f));
    if (hi == 0) li_l[r32] = l_reg;
    asm volatile("s_waitcnt lgkmcnt(0)" ::: "memory");
    int hi_e = hi, r32_e = r32, lane_e = lane; asm volatile("" : "+v"(hi_e), "+v"(r32_e), "+v"(lane_e));
    char* stg = lds + OFF_STG + wid * STG_WAVE;
    typedef float f32x4e __attribute__((ext_vector_type(4)));
    f32x4e liv[4];
#pragma unroll
    for (int k4 = 0; k4 < 4; ++k4) liv[k4] = *reinterpret_cast<const f32x4e*>(li_l + 8 * k4 + 4 * hi_e);
#pragma unroll
    for (int r = 0; r < 16; ++r) { const int orow = crow(r, hi_e); const float rl = 8.0f * __builtin_amdgcn_rcpf(liv[r >> 2][r & 3]);
#pragma unroll
        for (int d0 = 0; d0 < 4; ++d0) *(bf16*)(stg + orow * STG_ROW + (d0 * 32 + r32_e) * 2) = (bf16)(cvtpk(o[d0][r] * rl, 0.f) & 0xffffu); }
    asm volatile("s_waitcnt lgkmcnt(0)" ::: "memory");
    unsigned char* ow = u.out + (size_t)(wid * QBLK) * LDO;
#pragma unroll
    for (int i = 0; i < 4; ++i) { const int id = i * 64 + lane_e, row = id >> 3, c16 = (id & 7) * 16;
        const u32x4 oA = *reinterpret_cast<const u32x4*>(stg + row * STG_ROW + c16 * 2), oB = *reinterpret_cast<const u32x4*>(stg + row * STG_ROW + c16 * 2 + 16);
        u32x4 w;
#pragma unroll
        for (int h2 = 0; h2 < 2; ++h2) { const u32x4 gv = h2 ? gB[i] : gA[i], ov = h2 ? oB : oA; float y[8];
            typedef float f32x2 __attribute__((ext_vector_type(2)));
#pragma unroll
            for (int e = 0; e < 4; ++e) { const f32x2 g = {__uint_as_float(gv[e] << 16), __uint_as_float(gv[e] & 0xffff0000u)}, o2 = {__uint_as_float(ov[e] << 16), __uint_as_float(ov[e] & 0xffff0000u)};
                const f32x2 t = g * -1.4426950408889634f; f32x2 d = {__builtin_amdgcn_exp2f(t.x), __builtin_amdgcn_exp2f(t.y)}; d = d + 1.0f;
                const f32x2 r = {__builtin_amdgcn_rcpf(d.x), __builtin_amdgcn_rcpf(d.y)}, yy = o2 * (g * r);
                y[2 * e] = yy.x; y[2 * e + 1] = yy.y; }
            int w0 = 0, w1 = 0;
            w0 = __builtin_amdgcn_cvt_pk_fp8_f32(y[0], y[1], w0, false); w0 = __builtin_amdgcn_cvt_pk_fp8_f32(y[2], y[3], w0, true);
            w1 = __builtin_amdgcn_cvt_pk_fp8_f32(y[4], y[5], w1, false); w1 = __builtin_amdgcn_cvt_pk_fp8_f32(y[6], y[7], w1, true);
            w[2 * h2] = (unsigned)w0; w[2 * h2 + 1] = (unsigned)w1; }
        R.w[i] = w; }
    R.wp = ow + (size_t)(lane_e >> 3) * LDO + (lane_e & 7) * 16;
#undef ATT_SLOAD
#undef ATT_SWRITE
#undef ATT_SWAIT
#undef ATT_RESC
}
#undef KSWZ
#undef SBAR
}

constexpr int D = 4096, NCTX = 8192, NLAT = 8192, M_TOK = NCTX + NLAT;
constexpr int CTX_B = 32, CTX_L = 256, LAT_B = 8, LAT_L = 1024, PAST = 512, GRID_W = 64;
constexpr int HD = 128, NIN = 13312, NPIN = 8192;
constexpr int LDA = D + 64, LDG = 1024 + 64, LD8 = D + 128;
constexpr int C_QA = 0, C_KA = 2048, C_VA = 2560, C_QB = 3072, C_KB = 5120, C_VB = 7168, C_GATE = 9216;
constexpr int NCOND = 9, NMOD = 3 * D;
constexpr int KSPLIT = 16;
constexpr float NORM_EPS = 1e-6f;
constexpr size_t OFF_Y = 0, OFF_NAK = (size_t)M_TOK * D, OFF_NAV = OFF_NAK + (size_t)NCTX * 512, OFF_NBK = OFF_NAV + (size_t)NCTX * 512, OFF_NBV = OFF_NBK + (size_t)NCTX * 2048, OUT_TOTAL = OFF_NBV + (size_t)NCTX * 2048;

constexpr size_t MiB = 1u << 20;
constexpr size_t WS_CTL = 0, CTL_ZERO_BYTES = 32768;
constexpr size_t WS_MODP = 1 * MiB;
constexpr size_t WS_MODF = 15 * MiB;
constexpr size_t WS_WIN = 16 * MiB;
constexpr size_t WS_WKV = 70 * MiB;
constexpr size_t WS_WOUT = 122 * MiB;
constexpr size_t WS_WPIN = 155 * MiB;
constexpr size_t WS_WGRP = 220 * MiB;
constexpr size_t WS_WPOUT = 229 * MiB;
constexpr size_t WS_CAK = 262 * MiB, WS_CAV = 266 * MiB, WS_CBK = 270 * MiB, WS_CBV = 286 * MiB;
constexpr size_t WS_H = 302 * MiB;
constexpr size_t WS_H16 = 370 * MiB;
constexpr size_t WS_QKVG = 436 * MiB;
constexpr size_t WS_ATT = 852 * MiB;
constexpr size_t WS_X1 = 982 * MiB;
constexpr size_t WS_X2 = 1110 * MiB;
constexpr size_t WS_WU = 1238 * MiB;
constexpr size_t WS_WQ = 1272 * MiB;
constexpr size_t WS_WQ2 = 1306 * MiB;
constexpr size_t WS_END = 1324 * MiB;
constexpr size_t WS_ROPE = 15 * MiB + 1015808;
constexpr size_t WS_SCL = 15 * MiB + 917504;
static_assert(WS_WIN + (size_t)NIN * LD8 <= WS_WKV && WS_WKV + (size_t)5120 * LDA * 2 <= WS_WOUT && WS_WOUT + (size_t)D * LD8 <= WS_WPIN && WS_WPIN + (size_t)NPIN * LDA * 2 <= WS_WGRP && WS_WGRP + (size_t)4096 * LDG * 2 <= WS_WPOUT && WS_WPOUT + (size_t)D * LDA * 2 <= WS_CAK, "weights map");
static_assert(WS_H + (size_t)M_TOK * LD8 <= WS_H16 && WS_H16 + (size_t)NCTX * LDA * 2 <= WS_QKVG && WS_H + (size_t)M_TOK * LDA * 2 <= WS_QKVG && WS_QKVG + (size_t)M_TOK * NIN * 2 <= WS_ATT && WS_ATT + (size_t)M_TOK * LDA * 2 <= WS_X1 && WS_X1 + (size_t)M_TOK * D * 2 <= WS_X2 && WS_X2 + (size_t)M_TOK * D * 2 <= WS_WU && WS_WU + (size_t)D * LDA * 2 <= WS_WQ && WS_WQ + (size_t)NPIN * LD8 <= WS_WQ2 && WS_WQ2 + (size_t)D * LD8 <= WS_END && WS_MODF + (size_t)2 * NCOND * NMOD * 4 <= WS_SCL && WS_SCL + (M_TOK + NPIN + D) * 4 <= 16 * MiB, "activation map");
constexpr int CW_TMO = 0, CW_CODE = 1, CW_BAR = 4096;

constexpr int NWAVES = 8, NTHREADS = NWAVES * 64;
constexpr int LDS_BYTES = 150528;
constexpr int RING_OFF = 0, RING_BYTES = LDS_BYTES - 512;
constexpr int ROPE_LDS_OFF = 131072;
constexpr int LDSCTL_OFF = RING_BYTES, MISC_OFF = LDSCTL_OFF + 320;
static_assert(8 * 16640 <= RING_BYTES && MISC_OFF + 128 <= LDS_BYTES && (int)att::SHM_ATTN <= RING_BYTES && ROPE_LDS_OFF + 2 * 64 * pg8::ROPE_LD * 4 <= RING_BYTES, "LDS map");

#define GAS __attribute__((address_space(1)))
#define LAS __attribute__((address_space(3)))
typedef unsigned short bf16;
typedef unsigned v4u __attribute__((ext_vector_type(4)));
typedef unsigned v2u __attribute__((ext_vector_type(2)));
typedef float f32x4 __attribute__((ext_vector_type(4)));
typedef GAS unsigned gu32;
#define RLX_AGENT __ATOMIC_RELAXED, __HIP_MEMORY_SCOPE_AGENT
#define LDS_WAIT() asm volatile("s_waitcnt lgkmcnt(0)" ::: "memory")
#define VM_WAIT() asm volatile("s_waitcnt vmcnt(0)" ::: "memory")
__device__ __forceinline__ unsigned f2bf(float f) { unsigned u = __builtin_bit_cast(unsigned, f); return (u + 0x7fffu + ((u >> 16) & 1u)) >> 16; }
__device__ __forceinline__ unsigned pk2(float lo, float hi) { unsigned r; asm("v_cvt_pk_bf16_f32 %0, %1, %2" : "=v"(r) : "v"(lo), "v"(hi)); return r; }
__device__ __forceinline__ float bflo(unsigned w) { return __uint_as_float(w << 16); }
__device__ __forceinline__ float bfhi(unsigned w) { return __uint_as_float(w & 0xffff0000u); }
__device__ __forceinline__ float silu(float x) { return x / (1.0f + __expf(-x)); }
constexpr size_t QBLK_STRIDE = (size_t)M_TOK * HD;
__device__ __forceinline__ size_t qoff(size_t row, int col) { return (size_t)(col >> 7) * QBLK_STRIDE + row * HD + (col & 127); }


constexpr float S8_W = 256.0f, S8_ATT = 8.0f, S8_H = 4.0f;
__device__ __forceinline__ unsigned pk4_i8(float a, float b, float c, float d) {
    unsigned r = 0;
    r = __builtin_amdgcn_cvt_pk_u8_f32(a + 128.0f, 0, r); r = __builtin_amdgcn_cvt_pk_u8_f32(b + 128.0f, 1, r); r = __builtin_amdgcn_cvt_pk_u8_f32(c + 128.0f, 2, r); r = __builtin_amdgcn_cvt_pk_u8_f32(d + 128.0f, 3, r);
    return r ^ 0x80808080u;
}
__device__ __forceinline__ unsigned pk4_fp8(float a, float b, float c, float d) {
    int r = 0; r = __builtin_amdgcn_cvt_pk_fp8_f32(a, b, r, false); r = __builtin_amdgcn_cvt_pk_fp8_f32(c, d, r, true); return (unsigned)r;
}

#define XB_TMO      128
#define XB_XCNT(j)  (256  + 64 * (j))
#define XB_XSUB(j)  (1280 + 64 * (j))
#define XB_XGEN(j)  (2304 + 64 * (j))
#define XB_TOP      3328
#define XB_TOPGEN   3392
#define XCD_BAR_WORDS 3456
#define XB_SPIN_CAP (1u << 18)

__device__ __forceinline__ unsigned xb_ld(unsigned* p)              { return __hip_atomic_load(p, __ATOMIC_RELAXED, __HIP_MEMORY_SCOPE_AGENT); }
__device__ __forceinline__ unsigned xb_add(unsigned* p, unsigned v) { return __hip_atomic_fetch_add(p, v, __ATOMIC_RELAXED, __HIP_MEMORY_SCOPE_AGENT); }
__device__ __forceinline__ unsigned xb_xcc_id() { return (unsigned)__builtin_amdgcn_s_getreg((3 << 11) | 20) & 0xFu; }
#define XB_SPIN(cond, bar) do { unsigned _sp = 0; while (cond) { __builtin_amdgcn_s_sleep(1); \
    if ((++_sp & 255u) == 0u) { if (xb_ld(&(bar)[XB_TMO])) break; if (_sp > XB_SPIN_CAP) { atomicAdd(&(bar)[XB_TMO], 1u); break; } } } } while (0)

struct XcdBarrier {
    unsigned* bar; unsigned x;
    volatile LAS unsigned* st;
};

__device__ __forceinline__ XcdBarrier xcd_barrier_post(unsigned* bar, volatile LAS unsigned* st) {
    XcdBarrier b; b.bar = bar; b.x = xb_xcc_id(); b.st = st;
    if (threadIdx.x == 0) (void)xb_add(&bar[XB_XCNT(b.x)], 1u);
    return b;
}
__device__ __forceinline__ void xcd_barrier_complete(unsigned* bar, unsigned x, unsigned& nloc, unsigned& nx) {
    const unsigned G = gridDim.x * gridDim.y * gridDim.z;
    unsigned sum, cnt, mine, sp = 0u;
    for (;;) {
        sum = 0u; cnt = 0u; mine = 0u;
#pragma unroll
        for (unsigned j = 0; j < 16; ++j) { const unsigned c = xb_ld(&bar[XB_XCNT(j)]); sum += c; cnt += (c > 0u) ? 1u : 0u; mine = (j == x) ? c : mine; }
        if (sum == G) break;
        __builtin_amdgcn_s_sleep(1);
        if ((++sp & 255u) == 0u) { if (xb_ld(&bar[XB_TMO])) break; if (sp > XB_SPIN_CAP) { atomicAdd(&bar[XB_TMO], 1u); break; } }
    }
    nloc = mine > 0u ? mine : 1u; nx = cnt > 0u ? cnt : 1u;
}

__device__ __forceinline__ void xcd_barrier(const XcdBarrier& b) {
    asm volatile("s_waitcnt vmcnt(0)" ::: "memory");
    __syncthreads();
    if (threadIdx.x == 0) {
        unsigned* bar = b.bar;
        __builtin_amdgcn_s_waitcnt(0);
        unsigned nloc = b.st[0], nx = b.st[1];
        if (nloc == 0u) { xcd_barrier_complete(bar, b.x, nloc, nx); b.st[0] = nloc; b.st[1] = nx; }
        const unsigned old = xb_add(&bar[XB_XSUB(b.x)], 1u);
        const unsigned gen = old / nloc;
        if (old + 1u == (gen + 1u) * nloc) {
            __builtin_amdgcn_fence(__ATOMIC_RELEASE, "agent");
            asm volatile("s_waitcnt vmcnt(0)" ::: "memory");
            const unsigned og = xb_add(&bar[XB_TOP], 1u);
            const unsigned tg = og / nx;
            if (og + 1u == (tg + 1u) * nx) xb_add(&bar[XB_TOPGEN], 1u);
            else XB_SPIN(xb_ld(&bar[XB_TOPGEN]) == tg, bar);
            __builtin_amdgcn_fence(__ATOMIC_ACQUIRE, "agent");
            xb_add(&bar[XB_XGEN(b.x)], 1u);
            asm volatile("s_waitcnt vmcnt(0)" ::: "memory");
        } else {
            XB_SPIN(xb_ld(&bar[XB_XGEN(b.x)]) == gen, bar);
            __builtin_amdgcn_fence(__ATOMIC_ACQUIRE, "agent");
            asm volatile("s_waitcnt vmcnt(0)" ::: "memory");
        }
    }
    __syncthreads();
}
static_assert((size_t)(CW_BAR + XCD_BAR_WORDS) * 4 <= CTL_ZERO_BYTES, "the per-call memset covers the barrier words");

__device__ __forceinline__ float wave_sum(float v) {
#pragma unroll
    for (int o = 1; o < 64; o <<= 1) v += __shfl_xor(v, o);
    return v;
}

struct Frame {
    LAS unsigned char* lds;
    volatile LAS unsigned* MISC;
    gu32* ctl;
    int tid, lane, wave, vcu, G;
    const float *x_prompt, *x_sample, *c_lat, *cache_ak, *cache_av, *cache_bk, *cache_bv, *c_ctx, *w_ada, *b_ada, *norm_g, *w_in_attn, *a_sink, *b_rpb, *w_out_attn, *w_in_pool, *w_grp, *pool_scale, *w_out_pool, *final_g;
    float* out;
    float *modp, *modf, *sA1, *sW, *sW2; bf16 *X1, *X2; unsigned char *Wq, *Wq2;
    float* rope_tab;
    bf16 *Wt_in, *Wt_kv, *Wt_out, *Wt_pin, *Wt_grp, *Wt_pout, *Wu, *H16, *cak, *cav, *cbk, *cbv, *H, *QKVG, *ATT;
};

struct TItem { const float* src; unsigned char* d8; bf16* d16; int N, perm; };
constexpr int TI_IN = (D / 64) * (NIN / 64), TI_OUT = (D / 64) * (D / 64), TI_PIN = (D / 64) * (D / 64), TI_GRP1 = (1024 / 64) * (1024 / 64), TI_POUT = TI_OUT;
constexpr int TI_TOTAL = TI_IN + TI_OUT + TI_PIN + 4 * TI_GRP1 + TI_POUT;
__device__ __forceinline__ int rope_row(int n) { const int L = n & 255, head = L >> 7, blk = (L >> 6) & 1, half = (L >> 5) & 1, i = L & 31; return (n & ~255) + half * 128 + head * 64 + blk * 32 + i; }
__device__ __forceinline__ int kv_compact(int n) { return n < C_QB ? n - C_KA : n - C_KB + 1024; }
__device__ __forceinline__ TItem titem(Frame& F, int it, int& ld16) {
    const float* W; int N, ncols; int r = it; int kind;
    bf16* WT = nullptr;
    ld16 = LDA;
    if (r < TI_IN) { W = F.w_in_attn; N = NIN; ncols = NIN; kind = 0; }
    else if ((r -= TI_IN) < TI_OUT) { W = F.w_out_attn; N = D; ncols = D; kind = 1; }
    else if ((r -= TI_OUT) < TI_PIN) { W = F.w_in_pool + D; WT = F.Wt_pin + (size_t)D * LDA; N = NPIN; ncols = D; kind = 2; }
    else if ((r -= TI_PIN) < 4 * TI_GRP1) { const int g = r / TI_GRP1; r -= g * TI_GRP1; W = F.w_grp + (size_t)g * 1024 * 1024; WT = F.Wt_grp + (size_t)g * 1024 * LDG; N = 1024; ncols = 1024; ld16 = LDG; kind = 2; }
    else { r -= 4 * TI_GRP1; W = F.w_out_pool; WT = F.Wt_pout; N = D; ncols = D; kind = 2; }
    const int nblk = ncols / 64, kb = r / nblk, nb = r % nblk, n0 = 64 * nb, k0 = 64 * kb;
    TItem t; t.src = W + (size_t)k0 * N + n0; t.N = N; t.d8 = nullptr; t.d16 = nullptr; t.perm = -1;
    if (kind == 0) { t.d8 = (unsigned char*)F.Wt_in + (size_t)n0 * LD8 + k0; if (n0 < C_VA) { t.d8 = (unsigned char*)F.Wt_in + k0; t.perm = n0; }
        const bool kv = (n0 >= C_KA && n0 < C_QB) || (n0 >= C_KB && n0 < C_GATE); if (kv) t.d16 = F.Wt_kv + (size_t)kv_compact(n0) * LDA + k0; }
    else if (kind == 1) t.d8 = (unsigned char*)F.Wt_out + (size_t)n0 * LD8 + k0;
    else t.d16 = WT + (size_t)n0 * ld16 + k0;
    return t;
}
__device__ __forceinline__ void titem_load(f32x4 (&v)[16], const TItem& t, int lane) {
    const int q = lane >> 4, n4 = (lane & 15) * 4;
#pragma unroll
    for (int i = 0; i < 16; ++i) v[i] = __builtin_nontemporal_load((const GAS f32x4*)(t.src + (size_t)(4 * i + q) * t.N + n4));
}
__device__ __forceinline__ void titem_store(const f32x4 (&v)[16], const TItem& t, int ld16, LAS float* scr, int lane) {
    const int q = lane >> 4, n4 = (lane & 15) * 4;
#pragma unroll
    for (int i = 0; i < 16; ++i) { LAS float* d = scr + (4 * i + q) * 65 + n4; d[0] = v[i].x; d[1] = v[i].y; d[2] = v[i].z; d[3] = v[i].w; }
    LDS_WAIT(); asm volatile("" ::: "memory");
    const int c = lane & 7;
#pragma unroll
    for (int j = 0; j < 8; ++j) { const int n = (lane >> 3) + 8 * j; const LAS float* s = scr + (8 * c) * 65 + n;
        if (t.d8) { v2u o; o.x = pk4_fp8(s[0 * 65] * S8_W, s[1 * 65] * S8_W, s[2 * 65] * S8_W, s[3 * 65] * S8_W); o.y = pk4_fp8(s[4 * 65] * S8_W, s[5 * 65] * S8_W, s[6 * 65] * S8_W, s[7 * 65] * S8_W);
            *(GAS v2u*)(t.d8 + (size_t)(t.perm >= 0 ? rope_row(t.perm + n) : n) * LD8 + 8 * c) = o; }
        if (t.d16) { v4u o; o.x = pk2(s[0 * 65], s[1 * 65]); o.y = pk2(s[2 * 65], s[3 * 65]); o.z = pk2(s[4 * 65], s[5 * 65]); o.w = pk2(s[6 * 65], s[7 * 65]);
            *(GAS v4u*)(t.d16 + (size_t)n * ld16 + 8 * c) = o; } }
    LDS_WAIT(); asm volatile("" ::: "memory");
}
constexpr int ADA_NC = NMOD / 256, ADA_ITEMS = 2 * KSPLIT * ADA_NC, ADA_KS = D / KSPLIT;
__device__ __forceinline__ void p0_ada_item(Frame& F, int a) {
    const int l = a / (KSPLIT * ADA_NC), rem = a % (KSPLIT * ADA_NC), s = rem / ADA_NC, nc = rem % ADA_NC;
    const int k0 = s * ADA_KS, n0 = nc * 256 + F.lane * 4;
    f32x4 acc[NCOND];
#pragma unroll
    for (int j = 0; j < NCOND; ++j) acc[j] = (f32x4){0.f, 0.f, 0.f, 0.f};
    const float* wp = F.w_ada + ((size_t)l * D + k0) * NMOD + n0;
    for (int kb = 0; kb < ADA_KS / 64; ++kb) {
        float cv[NCOND];
        cv[0] = silu(F.c_ctx[k0 + kb * 64 + F.lane]);
#pragma unroll
        for (int j = 1; j < NCOND; ++j) cv[j] = silu(F.c_lat[(size_t)(j - 1) * D + k0 + kb * 64 + F.lane]);
#pragma unroll 16
        for (int kk = 0; kk < 64; ++kk) {
            const f32x4 w = __builtin_nontemporal_load((const f32x4*)(wp + (size_t)(kb * 64 + kk) * NMOD));
#pragma unroll
            for (int j = 0; j < NCOND; ++j) { const float cj = __builtin_bit_cast(float, __builtin_amdgcn_readlane(__builtin_bit_cast(int, cv[j]), kk)); acc[j] += w * cj; }
        }
    }
#pragma unroll
    for (int j = 0; j < NCOND; ++j) *(f32x4*)(F.modp + (((size_t)s * 2 + l) * NCOND + j) * NMOD + n0) = acc[j];
}
__device__ __forceinline__ void p0_prologue(Frame& F) {
    LAS float* scr = (LAS float*)(F.lds + RING_OFF + F.wave * 16640);
    const int gw = F.vcu * NWAVES + F.wave, NGW = F.G * NWAVES;
    for (int a = gw; a < ADA_ITEMS; a += NGW) p0_ada_item(F, a);
    int n, base, stride, off;
    if (NGW == 2048) { const bool ada = gw < ADA_ITEMS; n = ada ? 11 : 19; base = ada ? 0 : ADA_ITEMS * 11; stride = ada ? ADA_ITEMS : 2048 - ADA_ITEMS; off = ada ? gw : gw - ADA_ITEMS; }
    else { n = (TI_TOTAL - gw + NGW - 1) / NGW; base = 0; stride = NGW; off = gw; }
    if (n > 0) {
        f32x4 va[16], vb[16]; int la = LDA, lb = LDA;
        TItem ta = titem(F, base + off, la), tb = ta;
        titem_load(va, ta, F.lane);
        for (int i = 0; i < n; i += 2) {
            if (i + 1 < n) { tb = titem(F, base + (i + 1) * stride + off, lb); titem_load(vb, tb, F.lane); }
            titem_store(va, ta, la, scr, F.lane);
            if (i + 1 < n) {
                if (i + 2 < n) { ta = titem(F, base + (i + 2) * stride + off, la); titem_load(va, ta, F.lane); }
                titem_store(vb, tb, lb, scr, F.lane);
            }
        }
    }
    if (blockIdx.x == 0) for (int e = F.tid; e < 64 * 32; e += NTHREADS) {
        const int pos = e >> 5, i = e & 31; const float invf = exp2f(-(float)i * (13.287712379549449f / 32.0f));
        float sn, cs; sincosf((float)pos * invf, &sn, &cs); F.rope_tab[e] = cs; F.rope_tab[2048 + e] = sn; }
    for (int k = gw; k < D; k += NGW) {
        const float* src = F.w_in_pool + (size_t)k * NPIN; bf16* dst = F.Wu + (size_t)k * LDA;
#pragma unroll
        for (int q = 0; q < 8; ++q) { const int c = q * 512 + F.lane * 8; const f32x4 a = *(const GAS f32x4*)(src + c), b = *(const GAS f32x4*)(src + c + 4);
            v4u w; w.x = pk2(a.x, a.y); w.y = pk2(a.z, a.w); w.z = pk2(b.x, b.y); w.w = pk2(b.z, b.w); *(GAS v4u*)(dst + c) = w; }
    }
}

template <bool PART, class TX> __device__ __forceinline__ void norm_phase(Frame& F, const TX* xP, const TX* xS, const float* gvec, int layer) {
    LAS float* tA = (LAS float*)(F.lds + RING_OFF); LAS float* tB = tA + D;
    for (int rg = blockIdx.x; rg < M_TOK / 64; rg += F.G) {
        const int j = rg < NCTX / 64 ? 0 : 1 + (rg - NCTX / 64) / (LAT_L / 64);
        __syncthreads();
        for (int c = F.tid; c < D; c += NTHREADS) {
            float sh, sc;
            if (PART) { sh = F.b_ada[(size_t)layer * NMOD + c]; sc = F.b_ada[(size_t)layer * NMOD + D + c];
                for (int s = 0; s < KSPLIT; ++s) { const float* p = F.modp + (((size_t)s * 2 + layer) * NCOND + j) * NMOD; sh += p[c]; sc += p[D + c]; } }
            else { const float* p = F.modf + ((size_t)layer * NCOND + j) * NMOD; sh = p[c]; sc = p[D + c]; }
            tA[c] = gvec[c] * (1.0f + sc); tB[c] = sh;
        }
        __syncthreads();
        for (int i = 0; i < 8; ++i) {
            const int row = rg * 64 + F.wave * 8 + i;
            const TX* xr = row < NCTX ? xP + (size_t)row * D : xS + (size_t)(row - NCTX) * D;
            f32x4 v[16]; float ss = 0.f;
#pragma unroll
            for (int q = 0; q < 16; ++q) { if constexpr (sizeof(TX) == 4) v[q] = *(const f32x4*)(xr + q * 256 + F.lane * 4); else { const v2u w = *(const v2u*)(xr + q * 256 + F.lane * 4); v[q] = (f32x4){bflo(w.x), bfhi(w.x), bflo(w.y), bfhi(w.y)}; }
                ss += (v[q].x * v[q].x + v[q].y * v[q].y) + (v[q].z * v[q].z + v[q].w * v[q].w); }
            const float rstd = rsqrtf(wave_sum(ss) * (1.0f / D) + NORM_EPS);
            bf16* orow = F.H16 + (size_t)row * LDA; unsigned char* orow8 = (unsigned char*)F.H + (size_t)row * LD8;
            if (PART) {
                const bool w16 = row < NCTX;
#pragma unroll
                for (int q = 0; q < 16; ++q) { const int c = q * 256 + F.lane * 4; const f32x4 a = *(const LAS f32x4*)(tA + c), b = *(const LAS f32x4*)(tB + c);
                    const f32x4 o = v[q] * rstd * a + b;
                    if (w16) { v2u w; w.x = pk2(o.x, o.y); w.y = pk2(o.z, o.w); *(v2u*)(orow + c) = w; }
                    *(unsigned*)(orow8 + c) = pk4_fp8(o.x * S8_H, o.y * S8_H, o.z * S8_H, o.w * S8_H); }
            } else {
                float mx = 1e-20f;
#pragma unroll
                for (int q = 0; q < 16; ++q) { const int c = q * 256 + F.lane * 4; const f32x4 a = *(const LAS f32x4*)(tA + c), b = *(const LAS f32x4*)(tB + c);
                    v[q] = v[q] * rstd * a + b; mx = fmaxf(mx, fmaxf(fmaxf(fabsf(v[q].x), fabsf(v[q].y)), fmaxf(fabsf(v[q].z), fabsf(v[q].w)))); }
#pragma unroll
                for (int off = 1; off < 64; off <<= 1) mx = fmaxf(mx, __shfl_xor(mx, off));
                const float qi = 127.0f / mx;
                if (F.lane == 0) F.sA1[row] = mx * (1.0f / 127.0f);
#pragma unroll
                for (int q = 0; q < 16; ++q) { const int c = q * 256 + F.lane * 4; *(unsigned*)(orow8 + c) = pk4_i8(v[q].x * qi, v[q].y * qi, v[q].z * qi, v[q].w * qi); }
            }
        }
    }
    __syncthreads();
}

__device__ __forceinline__ void norm1_phase(Frame& F) {
    LAS float* tA = (LAS float*)(F.lds + RING_OFF); LAS float* tB = tA + D;
    const float* gvec = F.norm_g + D;
    for (int rg = blockIdx.x; rg < M_TOK / 64; rg += F.G) {
        const int j = rg < NCTX / 64 ? 0 : 1 + (rg - NCTX / 64) / (LAT_L / 64);
        __syncthreads();
        for (int c = F.tid; c < D; c += NTHREADS) { const float* p = F.modf + ((size_t)NCOND + j) * NMOD; tA[c] = gvec[c] * (1.0f + p[D + c]); tB[c] = p[c]; }
        __syncthreads();
#pragma unroll 1
        for (int hf = 0; hf < 4; ++hf) {
            const int row0 = rg * 64 + F.wave * 8 + hf * 2;
            v4u raw[2][8];
#pragma unroll
            for (int r = 0; r < 2; ++r) { const bf16* xr = F.X1 + (size_t)(row0 + r) * D + F.lane * 8;
#pragma unroll
                for (int k = 0; k < 8; ++k) raw[r][k] = *(const v4u*)(xr + k * 512); }
            asm volatile("" ::: "memory");
#pragma unroll
            for (int r = 0; r < 2; ++r) {
                float ss = 0.f;
#pragma unroll
                for (int k = 0; k < 8; ++k)
#pragma unroll
                    for (int e = 0; e < 4; ++e) { const float a = bflo(raw[r][k][e]), b = bfhi(raw[r][k][e]); ss += a * a + b * b; }
                const float rstd = rsqrtf(wave_sum(ss) * (1.0f / D) + NORM_EPS);
                float mx = 1e-20f;
#pragma unroll
                for (int k = 0; k < 8; ++k) { const int c = k * 512 + F.lane * 8;
                    const f32x4 a0 = *(const LAS f32x4*)(tA + c), a1 = *(const LAS f32x4*)(tA + c + 4), b0 = *(const LAS f32x4*)(tB + c), b1 = *(const LAS f32x4*)(tB + c + 4);
                    const v4u w = raw[r][k];
                    const f32x4 o0 = (f32x4){bflo(w[0]), bfhi(w[0]), bflo(w[1]), bfhi(w[1])} * rstd * a0 + b0, o1 = (f32x4){bflo(w[2]), bfhi(w[2]), bflo(w[3]), bfhi(w[3])} * rstd * a1 + b1;
                    mx = fmaxf(mx, fmaxf(fmaxf(fmaxf(fabsf(o0.x), fabsf(o0.y)), fmaxf(fabsf(o0.z), fabsf(o0.w))), fmaxf(fmaxf(fabsf(o1.x), fabsf(o1.y)), fmaxf(fabsf(o1.z), fabsf(o1.w)))));
                    raw[r][k] = (v4u){pk2(o0.x, o0.y), pk2(o0.z, o0.w), pk2(o1.x, o1.y), pk2(o1.z, o1.w)}; }
#pragma unroll
                for (int off = 1; off < 64; off <<= 1) mx = fmaxf(mx, __shfl_xor(mx, off));
                const float qi = 127.0f / mx;
                if (F.lane == 0) F.sA1[row0 + r] = mx * (1.0f / 127.0f);
                unsigned char* orow8 = (unsigned char*)F.H + (size_t)(row0 + r) * LD8 + F.lane * 8;
#pragma unroll
                for (int k = 0; k < 8; ++k) { const v4u w = raw[r][k]; v2u q;
                    q.x = pk4_i8(bflo(w[0]) * qi, bfhi(w[0]) * qi, bflo(w[1]) * qi, bfhi(w[1]) * qi); q.y = pk4_i8(bflo(w[2]) * qi, bfhi(w[2]) * qi, bflo(w[3]) * qi, bfhi(w[3]) * qi);
                    *(v2u*)(orow8 + k * 512) = q; }
                asm volatile("" ::: "memory");
            }
        }
    }
    __syncthreads();
}

__device__ __forceinline__ void norm0_phase(Frame& F) {
    LAS float* tA = (LAS float*)(F.lds + RING_OFF); LAS float* tB = tA + D;
    for (int rg = blockIdx.x; rg < M_TOK / 64; rg += F.G) {
        const int j = rg < NCTX / 64 ? 0 : 1 + (rg - NCTX / 64) / (LAT_L / 64);
        __syncthreads();
        for (int c = F.tid; c < D; c += NTHREADS) {
            float sh = F.b_ada[c], sc = F.b_ada[D + c];
            for (int s = 0; s < KSPLIT; ++s) { const float* p = F.modp + (((size_t)s * 2) * NCOND + j) * NMOD; sh += p[c]; sc += p[D + c]; }
            tA[c] = F.norm_g[c] * (1.0f + sc); tB[c] = sh;
        }
        __syncthreads();
#pragma unroll 1
        for (int hf = 0; hf < 4; ++hf) {
            const int row0 = rg * 64 + F.wave * 8 + hf * 2;
            f32x4 raw[2][16];
#pragma unroll
            for (int r = 0; r < 2; ++r) { const int row = row0 + r; const float* xr = (row < NCTX ? F.x_prompt + (size_t)row * D : F.x_sample + (size_t)(row - NCTX) * D) + F.lane * 4;
#pragma unroll
                for (int q = 0; q < 16; ++q) raw[r][q] = *(const f32x4*)(xr + q * 256); }
            asm volatile("" ::: "memory");
#pragma unroll
            for (int r = 0; r < 2; ++r) { const int row = row0 + r;
                float ss = 0.f;
#pragma unroll
                for (int q = 0; q < 16; ++q) { const f32x4 v = raw[r][q]; ss += (v.x * v.x + v.y * v.y) + (v.z * v.z + v.w * v.w); }
                const float rstd = rsqrtf(wave_sum(ss) * (1.0f / D) + NORM_EPS);
                bf16* orow = F.H16 + (size_t)row * LDA; unsigned char* orow8 = (unsigned char*)F.H + (size_t)row * LD8; const bool w16 = row < NCTX;
#pragma unroll
                for (int q = 0; q < 16; ++q) { const int c = q * 256 + F.lane * 4; const f32x4 a = *(const LAS f32x4*)(tA + c), b = *(const LAS f32x4*)(tB + c);
                    const f32x4 o = raw[r][q] * rstd * a + b;
                    if (w16) { v2u w; w.x = pk2(o.x, o.y); w.y = pk2(o.z, o.w); *(v2u*)(orow + c) = w; }
                    *(unsigned*)(orow8 + c) = pk4_fp8(o.x * S8_H, o.y * S8_H, o.z * S8_H, o.w * S8_H); }
                asm volatile("" ::: "memory");
            }
        }
    }
    __syncthreads();
}
__device__ __forceinline__ void p1_extras(Frame& F) {
    const int gt = blockIdx.x * NTHREADS + F.tid, NT = F.G * NTHREADS;
    for (int idx = gt; idx < 2 * NCOND * NMOD; idx += NT) {
        const int l = idx / (NCOND * NMOD), n = idx % NMOD; float v = F.b_ada[(size_t)l * NMOD + n];
        for (int s = 0; s < KSPLIT; ++s) v += F.modp[(size_t)s * 2 * NCOND * NMOD + idx];
        F.modf[idx] = v;
    }
}
__device__ __forceinline__ void cache_convert(Frame& F, int wt, int WT) {
    constexpr size_t NA8 = (size_t)LAT_B * PAST * 512 / 8, NB8 = (size_t)LAT_B * PAST * 2048 / 8, NTOT = 2 * NA8 + 2 * NB8;
    for (size_t i0 = wt; i0 < NTOT; i0 += (size_t)4 * WT) {
        f32x4 a[4], b[4]; bf16* dp[4];
#pragma unroll
        for (int u = 0; u < 4; ++u) { const size_t i = i0 + (size_t)u * WT; dp[u] = nullptr;
            if (i < NTOT) { const float* src; bf16* dst; size_t k = i;
                if (k < NA8) { src = F.cache_ak; dst = F.cak; } else if ((k -= NA8) < NA8) { src = F.cache_av; dst = F.cav; } else if ((k -= NA8) < NB8) { src = F.cache_bk; dst = F.cbk; } else { k -= NB8; src = F.cache_bv; dst = F.cbv; }
                a[u] = *(const f32x4*)(src + k * 8); b[u] = *(const f32x4*)(src + k * 8 + 4);
                const int lc = dst == F.cak || dst == F.cav ? 9 : 11;
                const size_t e = k * 8, row = e >> lc, col = e & (((size_t)1 << lc) - 1);
                dp[u] = dst + (col >> 7) * ((size_t)LAT_B * PAST * HD) + row * HD + (col & 127); } }
#pragma unroll
        for (int u = 0; u < 4; ++u) if (dp[u]) { v4u w; w.x = pk2(a[u].x, a[u].y); w.y = pk2(a[u].z, a[u].w); w.z = pk2(b[u].x, b[u].y); w.w = pk2(b[u].z, b[u].w); *(v4u*)dp[u] = w; }
    }
}


__device__ __forceinline__ void quant_weight_rows(Frame& F, const bf16* src, unsigned char* dst, float* sc, int nrows, int gw, int NGW) {
    for (int r0 = gw; r0 < nrows; r0 += 2 * NGW) {
        v4u x[2][8]; const int r1 = r0 + NGW < nrows ? r0 + NGW : r0;
#pragma unroll
        for (int q = 0; q < 8; ++q) { x[0][q] = *(const v4u*)(src + (size_t)r0 * LDA + q * 512 + F.lane * 8); x[1][q] = *(const v4u*)(src + (size_t)r1 * LDA + q * 512 + F.lane * 8); }
#pragma unroll
        for (int u = 0; u < 2; ++u) { const int r = u ? r1 : r0; if (u && r1 == r0) break;
            float mx = 1e-20f;
#pragma unroll
            for (int q = 0; q < 8; ++q)
#pragma unroll
                for (int e = 0; e < 4; ++e) mx = fmaxf(mx, fmaxf(fabsf(bflo(x[u][q][e])), fabsf(bfhi(x[u][q][e]))));
#pragma unroll
            for (int off = 1; off < 64; off <<= 1) mx = fmaxf(mx, __shfl_xor(mx, off));
            const float qi = 127.0f / mx; if (F.lane == 0) sc[r] = mx * (1.0f / 127.0f);
            unsigned char* o = dst + (size_t)r * LD8;
#pragma unroll
            for (int q = 0; q < 8; ++q) { v2u w; w.x = pk4_i8(bflo(x[u][q][0]) * qi, bfhi(x[u][q][0]) * qi, bflo(x[u][q][1]) * qi, bfhi(x[u][q][1]) * qi); w.y = pk4_i8(bflo(x[u][q][2]) * qi, bfhi(x[u][q][2]) * qi, bflo(x[u][q][3]) * qi, bfhi(x[u][q][3]) * qi);
                *(v2u*)(o + q * 512 + F.lane * 8) = w; } }
    }
}

__device__ __forceinline__ void side_jobs(Frame& F, int gw, int NGW) {
    quant_weight_rows(F, F.Wt_pin, F.Wq, F.sW, NPIN, gw, NGW); quant_weight_rows(F, F.Wt_pout, F.Wq2, F.sW2, D, gw, NGW);
    cache_convert(F, gw * 64 + F.lane, NGW * 64);
}
__device__ __forceinline__ att::Unit attn_make_unit(Frame& F, int w, int e) {
    const int kind = w >> 8, p = w & 255, idx = 2 * p + e;
    att::Unit u;
    u.kc = nullptr; u.vc = nullptr; u.nctx = 0; u.mask = 0; u.qpos0 = 0; u.kpos0 = 0; u.has_sink = 0; u.sink_i = 0; u.rpb = F.b_rpb;
    if (kind < 2) {
        const int b = idx >> 4, h = idx & 15; const size_t row0 = (size_t)b * CTX_L;
        const int qc = kind ? C_QB + h * HD : C_QA + h * HD, kcol = kind ? C_KB + h * HD : C_KA + (h >> 2) * HD, vcol = kind ? C_VB + h * HD : C_VA + (h >> 2) * HD, oc = kind * 2048 + h * HD;
        u.q = F.QKVG + qoff(row0, qc); u.kl = F.QKVG + qoff(row0, kcol); u.vl = F.QKVG + qoff(row0, vcol); u.nt = 4;
        if (kind == 0) { u.has_sink = 1; u.sink_i = h; }
        u.gate = F.QKVG + qoff(row0, C_GATE + oc); u.out = (unsigned char*)F.ATT + row0 * LD8 + oc;
    } else {
        const int qb = idx & 3, h = (idx >> 2) & 15, b = idx >> 6; const size_t seq0 = (size_t)NCTX + (size_t)b * LAT_L, row0 = seq0 + qb * 256;
        u.nctx = 8;
        if (kind == 2) {
            const int kstart = qb == 0 ? 0 : qb * 256 - 128, nloc = (qb == 0 || qb == 3) ? 6 : 8, kvh = h >> 2;
            u.q = F.QKVG + qoff(row0, C_QA + h * HD);
            u.kc = F.cak + ((size_t)kvh * LAT_B + b) * PAST * HD; u.vc = F.cav + ((size_t)kvh * LAT_B + b) * PAST * HD;
            u.kl = F.QKVG + qoff(seq0 + kstart, C_KA + kvh * HD); u.vl = F.QKVG + qoff(seq0 + kstart, C_VA + kvh * HD);
            u.nt = 8 + nloc; u.mask = 1; u.qpos0 = qb * 256; u.kpos0 = kstart; u.has_sink = 1; u.sink_i = h;
            u.gate = F.QKVG + qoff(row0, C_GATE + h * HD); u.out = (unsigned char*)F.ATT + row0 * LD8 + h * HD;
        } else {
            const int krow0 = qb < 2 ? 0 : (qb == 2 ? 4 : 8), nloc = (qb == 0 || qb == 3) ? 8 : 12;
            u.q = F.QKVG + qoff(row0, C_QB + h * HD);
            u.kc = F.cbk + ((size_t)h * LAT_B + b) * PAST * HD; u.vc = F.cbv + ((size_t)h * LAT_B + b) * PAST * HD;
            u.kl = F.QKVG + qoff(seq0 + krow0 * GRID_W, C_KB + h * HD); u.vl = F.QKVG + qoff(seq0 + krow0 * GRID_W, C_VB + h * HD);
            u.nt = 8 + nloc; u.mask = 2; u.qpos0 = qb * 4; u.kpos0 = krow0; u.rpb = F.b_rpb + (size_t)h * 15 * 31;
            u.gate = F.QKVG + qoff(row0, C_GATE + 2048 + h * HD); u.out = (unsigned char*)F.ATT + row0 * LD8 + 2048 + h * HD;
        }
    }
    return u;
}
__device__ __forceinline__ void attn_phase(Frame& F, char* lds, int wlimit = 1024) {
    const int nw = F.vcu < wlimit ? (wlimit - 1 - F.vcu) / F.G + 1 : 0, n = 2 * nw;
    if (n == 0) return;
    att::Regs R;
    if (F.tid < 16) ((float*)(lds + att::OFF_SINK))[F.tid] = F.a_sink[F.tid];
    const int rot = n == 8 ? 2 * ((F.vcu >> 3) & 3) : 0;
#define ATT_UNIT_OF(k_) attn_make_unit(F, F.vcu + ((n == 8 ? ((k_) + rot) & 7 : (k_)) >> 1) * F.G, (k_) & 1)
    att::Unit cur = ATT_UNIT_OF(0), nxt = cur;
    att::attn_prefetch(cur, R);
    for (int k = 0; k < n; ++k) {
        const bool has_next = k + 1 < n;
        if (has_next) nxt = ATT_UNIT_OF(k + 1);
        att::attn_unit(cur, has_next, nxt, R, lds, k > 0);
        cur = nxt;
    }
    att::attn_flush(R);
#undef ATT_UNIT_OF
}

__device__ __forceinline__ void pool_phase(Frame& F) {
    typedef float f32x2 __attribute__((ext_vector_type(2)));
    LAS v4u* ring = (LAS v4u*)(F.lds + RING_OFF) + F.tid;
    LAS float* pss = (LAS float*)(F.lds + RING_OFF + 16 * NTHREADS * 16);
    LAS float* qinv = pss + 8 * NTHREADS;
    static_assert(16 * NTHREADS * 16 + 8 * NTHREADS * 4 + 64 <= RING_BYTES, "pool LDS");
    const bf16* U = F.QKVG; unsigned char* Yq = (unsigned char*)F.ATT;
    const int col = F.tid * 8, half = 1 << (col >> 10);
    f32x2 psc2[4];
#pragma unroll
    for (int e = 0; e < 4; ++e) psc2[e] = (f32x2){F.pool_scale[col + 2 * e], F.pool_scale[col + 2 * e + 1]};
    for (int chunk = blockIdx.x; chunk < M_TOK / 64; chunk += F.G) {
        const int m0 = chunk * 64; int seq0, n;
        if (m0 < NCTX) { seq0 = m0 & ~(CTX_L - 1); n = CTX_L; } else { seq0 = NCTX + ((m0 - NCTX) & ~(LAT_L - 1)); n = LAT_L; }
        const int tl0 = m0 - seq0; const bf16* up = U + (size_t)seq0 * NPIN + col;
        f32x2 S2[4];
#pragma unroll
        for (int e = 0; e < 4; ++e) S2[e] = (f32x2){0.f, 0.f};
        { const int lo = tl0 - half < 0 ? 0 : tl0 - half, hi = tl0 + half > n ? n : tl0 + half;
          for (int tt = lo; tt < hi; ++tt) { const v4u ww = *(const v4u*)(up + (size_t)tt * NPIN); ring[(tt & 15) * NTHREADS] = ww;
#pragma unroll
              for (int e = 0; e < 4; ++e) S2[e] = S2[e] + (f32x2){bflo(ww[e]), bfhi(ww[e])}; } }
        v4u gat[2][4], add[2][4];
#define POOL_LOAD(b, g) do { _Pragma("unroll") for (int j = 0; j < 4; ++j) { const int t = tl0 + (g) * 4 + j; const int ta = t + half < n ? t + half : t; \
            gat[b][j] = *(const v4u*)(up + (size_t)t * NPIN + D); add[b][j] = *(const v4u*)(up + (size_t)ta * NPIN); } } while (0)
        POOL_LOAD(0, 0);
#pragma unroll 1
        for (int sub = 0; sub < 8; ++sub) {
            v4u yb[8];
#pragma unroll
            for (int gi = 0; gi < 2; ++gi) {
                const int g = sub * 2 + gi, gn = g + 1 < 16 ? g + 1 : 15;
                POOL_LOAD(gi ^ 1, gn);
                asm volatile("" ::: "memory");
#pragma unroll
                for (int j = 0; j < 4; ++j) { const int t = tl0 + g * 4 + j;
                    const int lo = t - half < 0 ? 0 : t - half, hi = t + half > n ? n : t + half; const float inv = __builtin_amdgcn_rcpf((float)(hi - lo));
                    const bool ha = t + half < n, hr = t - half >= 0;
                    const v4u cur = ring[(t & 15) * NTHREADS], rem = ring[((t - half) & 15) * NTHREADS];
                    if (ha) ring[((t + half) & 15) * NTHREADS] = add[gi][j];
                    float ss = 0.f;
#pragma unroll
                    for (int e = 0; e < 4; ++e) {
                        const f32x2 u2 = {bflo(cur[e]), bfhi(cur[e])}, g2 = {bflo(gat[gi][j][e]), bfhi(gat[gi][j][e])};
                        const f32x2 m2 = (S2[e] * inv - u2) * psc2[e];
                        const f32x2 t2 = g2 * -1.4426950408889634f; f32x2 d2 = {__builtin_amdgcn_exp2f(t2.x), __builtin_amdgcn_exp2f(t2.y)}; d2 = d2 + 1.0f;
                        const f32x2 r2 = {__builtin_amdgcn_rcpf(d2.x), __builtin_amdgcn_rcpf(d2.y)}, y2 = m2 * (g2 * r2);
                        ss = fmaxf(ss, fmaxf(fabsf(y2.x), fabsf(y2.y)));
                        yb[gi * 4 + j][e] = pk2(y2.x, y2.y);
                        const unsigned aw = ha ? add[gi][j][e] : 0u, rw = hr ? rem[e] : 0u;
                        S2[e] = S2[e] + ((f32x2){bflo(aw), bfhi(aw)} - (f32x2){bflo(rw), bfhi(rw)}); }
                    pss[(gi * 4 + j) * NTHREADS + F.tid] = ss; }
                asm volatile("" ::: "memory");
            }
            __syncthreads();
            { const int tok = F.wave; float a = 0.f;
#pragma unroll
              for (int i = 0; i < 8; ++i) a = fmaxf(a, pss[tok * NTHREADS + i * 64 + F.lane]);
#pragma unroll
              for (int off = 1; off < 64; off <<= 1) a = fmaxf(a, __shfl_xor(a, off));
              if (F.lane == 0) { const float step = fmaxf(a, 1e-20f) * (1.0f / 127.0f); qinv[tok] = 1.0f / step; F.sA1[seq0 + tl0 + sub * 8 + tok] = step; } }
            __syncthreads();
#pragma unroll
            for (int j = 0; j < 8; ++j) { const float qi = qinv[j]; float q[8];
#pragma unroll
                for (int e = 0; e < 4; ++e) { q[2 * e] = bflo(yb[j][e]) * qi; q[2 * e + 1] = bfhi(yb[j][e]) * qi; }
                v2u w; w.x = pk4_i8(q[0], q[1], q[2], q[3]); w.y = pk4_i8(q[4], q[5], q[6], q[7]);
                *(v2u*)(Yq + (size_t)(seq0 + tl0 + sub * 8 + j) * LD8 + col) = w; }
        }
#undef POOL_LOAD
    }
    __syncthreads();
}

__device__ __forceinline__ void final_norm_phase(Frame& F) {
    const int gw = F.vcu * NWAVES + F.wave, NGW = F.G * NWAVES;
    v2u raw[16];
    if (gw < M_TOK) { const bf16* xr = F.X2 + (size_t)gw * D;
#pragma unroll
        for (int q = 0; q < 16; ++q) raw[q] = *(const v2u*)(xr + q * 256 + F.lane * 4); }
    for (int row = gw; row < M_TOK; row += NGW) {
        float* yr = F.out + OFF_Y + (size_t)row * D;
        f32x4 v[16]; float ss = 0.f;
#pragma unroll
        for (int q = 0; q < 16; ++q) { const v2u w = raw[q]; v[q] = (f32x4){bflo(w.x), bfhi(w.x), bflo(w.y), bfhi(w.y)}; ss += (v[q].x * v[q].x + v[q].y * v[q].y) + (v[q].z * v[q].z + v[q].w * v[q].w); }
        if (row + NGW < M_TOK) { const bf16* xn = F.X2 + (size_t)(row + NGW) * D;
#pragma unroll
            for (int q = 0; q < 16; ++q) raw[q] = *(const v2u*)(xn + q * 256 + F.lane * 4); }
        const float rstd = rsqrtf(wave_sum(ss) * (1.0f / D) + NORM_EPS);
#pragma unroll
        for (int q = 0; q < 16; ++q) { const int c = q * 256 + F.lane * 4; const f32x4 g = *(const f32x4*)(F.final_g + c); *(f32x4*)(yr + c) = v[q] * rstd * g; }
    }
}

constexpr int N_PHASES = 12;
constexpr int N_LAUNCHES = MK_N_LAUNCHES;
struct Args { const float* in[20]; float* out; unsigned char* ws; int ph_lo, ph_hi; };
static_assert(sizeof(Args) == 20 * 8 + 8 + 8 + 8, "Args has no padding");
__global__ void __launch_bounds__(NTHREADS, 2) fwd_kernel(Args args) {
    extern __shared__ __attribute__((aligned(16))) unsigned char lds[];
    Frame F;
    F.lds = (LAS unsigned char*)lds;
    F.MISC = (volatile LAS unsigned*)(F.lds + MISC_OFF);
    F.tid = threadIdx.x; F.lane = F.tid & 63; F.wave = __builtin_amdgcn_readfirstlane(F.tid >> 6);
    F.G = gridDim.x; { const int bx = blockIdx.x; F.vcu = (F.G % 8 == 0) ? (bx % 8) * (F.G / 8) + bx / 8 : bx; }
    unsigned char* ws = args.ws;
    F.ctl = (gu32*)(ws + WS_CTL);
    F.x_prompt = args.in[0]; F.x_sample = args.in[1]; F.c_lat = args.in[2]; F.cache_ak = args.in[3]; F.cache_av = args.in[4]; F.cache_bk = args.in[5]; F.cache_bv = args.in[6];
    F.c_ctx = args.in[7]; F.w_ada = args.in[8]; F.b_ada = args.in[9]; F.norm_g = args.in[10]; F.w_in_attn = args.in[11]; F.a_sink = args.in[12]; F.b_rpb = args.in[13];
    F.w_out_attn = args.in[14]; F.w_in_pool = args.in[15]; F.w_grp = args.in[16]; F.pool_scale = args.in[17]; F.w_out_pool = args.in[18]; F.final_g = args.in[19];
    F.out = args.out;
    F.modp = (float*)(ws + WS_MODP); F.modf = (float*)(ws + WS_MODF); F.X1 = (bf16*)(ws + WS_X1); F.X2 = (bf16*)(ws + WS_X2); F.sA1 = (float*)(ws + WS_SCL); F.sW = F.sA1 + M_TOK; F.sW2 = F.sW + NPIN; F.Wq = ws + WS_WQ; F.Wq2 = ws + WS_WQ2;
    F.Wt_in = (bf16*)(ws + WS_WIN); F.Wt_kv = (bf16*)(ws + WS_WKV); F.H16 = (bf16*)(ws + WS_H16); F.Wt_out = (bf16*)(ws + WS_WOUT); F.Wt_pin = (bf16*)(ws + WS_WPIN); F.Wt_grp = (bf16*)(ws + WS_WGRP); F.Wt_pout = (bf16*)(ws + WS_WPOUT); F.Wu = (bf16*)(ws + WS_WU);
    F.cak = (bf16*)(ws + WS_CAK); F.cav = (bf16*)(ws + WS_CAV); F.cbk = (bf16*)(ws + WS_CBK); F.cbv = (bf16*)(ws + WS_CBV);
    F.rope_tab = (float*)(ws + WS_ROPE);
    F.H = (bf16*)(ws + WS_H); F.QKVG = (bf16*)(ws + WS_QKVG); F.ATT = (bf16*)(ws + WS_ATT);
    for (int u = F.tid; u < (LDS_BYTES - LDSCTL_OFF) / 4; u += NTHREADS) ((LAS unsigned*)(F.lds + LDSCTL_OFF))[u] = 0u;
    __syncthreads();
    XcdBarrier bar; bar.bar = (unsigned*)(F.ctl + CW_BAR); bar.x = 0; bar.st = nullptr;
    if (N_LAUNCHES == 1) bar = xcd_barrier_post((unsigned*)(F.ctl + CW_BAR), F.MISC + 8);
#define GRID_BAR() do { if (N_LAUNCHES == 1) xcd_barrier(bar); } while (0)
    const int lo = args.ph_lo, hi = args.ph_hi;
#define REFRESH() do { int t_ = threadIdx.x; asm volatile("" : "+v"(t_)); F.tid = t_; F.lane = t_ & 63; F.wave = __builtin_amdgcn_readfirstlane(t_ >> 6); } while (0)
#ifndef PROBE_REP
#define PROBE_REP -1
#endif
#ifndef PROBE_ATT_LIMIT
#define PROBE_ATT_LIMIT 1024
#endif
#define IN(k) (lo <= (k) && (k) < hi)
#define REPS(k) for (int rep_ = 0; rep_ < ((k) == PROBE_REP ? 2 : 1); ++rep_)
#define BOTH(k) (IN(k) && IN((k) + 1))
    typedef pg8::bf16_t pb;

    if (IN(0)) REPS(0) { REFRESH(); if (rep_) GRID_BAR(); p0_prologue(F); if (BOTH(0)) GRID_BAR(); }
    if (IN(1)) REPS(1) { REFRESH(); if (rep_) GRID_BAR(); p1_extras(F); norm0_phase(F);
        {
            pg8::Gemm g{(const pb*)F.Wt_grp, (const pb*)F.Wu, D, D, 1024, LDG, LDA, 0, 4}; pg8::StaticOrder S; S.init(D, D, F.G, (int)blockIdx.x);
            pg8::EpiBf16 E{(pb*)F.Wt_pin, LDA, 128, 1.0f};
            pg8::gemm_phase<pg8::EpiBf16, pg8::StaticOrder, true, true>(F.lds + RING_OFF, g, S, E);
        }
        if (BOTH(1)) GRID_BAR(); }
    if (IN(2)) REPS(2) { REFRESH(); if (rep_) GRID_BAR();
        for (int e = F.tid; e < 4096; e += NTHREADS) ((LAS float*)(F.lds + ROPE_LDS_OFF))[(e >> 5) * pg8::ROPE_LD + (e & 31)] = F.rope_tab[e];
        __syncthreads();
        {
            pg8::Gemm g{(const pb*)F.H16, (const pb*)F.Wt_kv, NCTX, 5120, D, LDA, LDA, 0, 0}; pg8::StaticOrder S; S.init(NCTX, 5120, F.G, F.G - 1 - (int)blockIdx.x);
            pg8::EpiKV E{(pb*)F.QKVG, HD, QBLK_STRIDE, F.out + OFF_NAK, F.out + OFF_NAV, F.out + OFF_NBK, F.out + OFF_NBV};
            pg8::gemm_phase<pg8::EpiKV, pg8::StaticOrder, true, true>(F.lds + RING_OFF, g, S, E);
        }
        {
            pg8::Gemm g{(const pb*)F.H, (const pb*)F.Wt_in, M_TOK, NIN, D, LD8, LD8, 0, 0}; pg8::MixedOrder S; S.init(F.G, (int)blockIdx.x);
            pg8::EpiQKVG E{(pb*)F.QKVG, HD, QBLK_STRIDE, 1.0f / (S8_H * S8_W), (const PG8_LAS float*)(F.lds + ROPE_LDS_OFF)};
            pg8::gemm_phase<pg8::EpiQKVG, pg8::MixedOrder, true, true, 1>(F.lds + RING_OFF, g, S, E);
        }
#ifndef PROBE_SIDE
#define PROBE_SIDE 1
#endif
        if (F.G == 256 && blockIdx.x >= 128) { REFRESH(); for (int sj_ = 0; sj_ < PROBE_SIDE; ++sj_) side_jobs(F, ((int)blockIdx.x - 128) * NWAVES + F.wave, 128 * NWAVES); }
        if (BOTH(2)) GRID_BAR();
    }
    if (IN(3) && F.G != 256) { REFRESH(); side_jobs(F, F.vcu * NWAVES + F.wave, F.G * NWAVES); if (BOTH(3)) GRID_BAR(); }
    if (IN(4)) REPS(4) { REFRESH(); if (rep_) GRID_BAR(); attn_phase(F, (char*)lds + RING_OFF, rep_ ? PROBE_ATT_LIMIT : 1024); if (BOTH(4)) GRID_BAR(); }
    if (IN(5)) REPS(5) { REFRESH(); if (rep_) GRID_BAR();
        pg8::Gemm g{(const pb*)F.ATT, (const pb*)F.Wt_out, M_TOK, D, D, LD8, LD8, 0, 0}; pg8::StaticOrder S; S.init(M_TOK, D, F.G, (int)blockIdx.x);
        typedef pg8::EpiResT<float, pb, false> Epi2;
        Epi2 E{F.x_prompt, F.x_sample, (pb*)F.X1, D, F.modf + 2 * D, 1.0f / (S8_W * S8_ATT), nullptr, nullptr};
        pg8::gemm_phase<Epi2, pg8::StaticOrder, true, true, 1>(F.lds + RING_OFF, g, S, E);
        if (BOTH(5)) GRID_BAR();
    }
    if (IN(6)) REPS(6) { REFRESH(); if (rep_) GRID_BAR(); norm1_phase(F); if (BOTH(6)) GRID_BAR(); }
    if (IN(7)) REPS(7) { REFRESH(); if (rep_) GRID_BAR();
        pg8::Gemm g{(const pb*)F.H, (const pb*)F.Wq, M_TOK, NPIN, D, LD8, LD8, 0, 0}; pg8::StaticOrder S; S.init(M_TOK, NPIN, F.G, (int)blockIdx.x);
        pg8::EpiI8 E{(pb*)F.QKVG, NPIN, F.sA1, F.sW};
        pg8::gemm_phase<pg8::EpiI8, pg8::StaticOrder, true, true, 2>(F.lds + RING_OFF, g, S, E);
        if (BOTH(7)) GRID_BAR();
    }
    if (IN(8)) REPS(8) { REFRESH(); if (rep_) GRID_BAR(); pool_phase(F); if (BOTH(8)) GRID_BAR(); }
    if (IN(10)) REPS(10) { REFRESH(); if (rep_) GRID_BAR();
        pg8::Gemm g{(const pb*)F.ATT, (const pb*)F.Wq2, M_TOK, D, D, LD8, LD8, 0, 0}; pg8::StaticOrder S; S.init(M_TOK, D, F.G, (int)blockIdx.x);
        typedef pg8::EpiResT<pb, pb, true> Epi5;
        Epi5 E{(const pb*)F.X1, (const pb*)F.X1 + (size_t)NCTX * D, (pb*)F.X2, D, F.modf + (size_t)NCOND * NMOD + 2 * D, 1.0f, F.sA1, F.sW2};
        pg8::gemm_phase<Epi5, pg8::StaticOrder, true, true, 2>(F.lds + RING_OFF, g, S, E);
        if (BOTH(10)) GRID_BAR();
    }
    if (IN(11)) REPS(11) { REFRESH(); if (rep_) GRID_BAR(); final_norm_phase(F); }
#undef IN
#undef REPS
#undef REFRESH
#undef BOTH
#undef GRID_BAR
}

extern "C" void kernel_launch(void* const* d_in, const int* in_sizes, int n_in, void* d_out, int out_size, void* d_ws, size_t ws_size, hipStream_t stream) {
    static int grid = 0;
    if (grid == 0) {
        if (n_in != 20 || (size_t)out_size != OUT_TOTAL || ws_size < WS_END) { fprintf(stderr, "kernel_launch: unexpected shapes: n_in %d out %d ws %zu (need %zu)\n", n_in, out_size, ws_size, (size_t)WS_END); grid = -1; return; }
        int dev = 0, cus = 0, per_cu = 0;
        if (hipGetDevice(&dev) != hipSuccess || hipDeviceGetAttribute(&cus, hipDeviceAttributeMultiprocessorCount, dev) != hipSuccess) { grid = -1; return; }
        if (hipFuncSetAttribute((const void*)fwd_kernel, hipFuncAttributeMaxDynamicSharedMemorySize, LDS_BYTES) != hipSuccess) { fprintf(stderr, "kernel_launch: hipFuncSetAttribute failed\n"); grid = -1; return; }
        if (hipOccupancyMaxActiveBlocksPerMultiprocessor(&per_cu, (const void*)fwd_kernel, NTHREADS, LDS_BYTES) != hipSuccess || per_cu < 1) fprintf(stderr, "kernel_launch: occupancy query says %d\n", per_cu);
        (void)hipGetLastError();
        grid = cus;
    }
    if (grid < 0) return;
    if (hipMemsetAsync((char*)d_ws + WS_CTL, 0, CTL_ZERO_BYTES, stream) != hipSuccess) return;
    Args a{};
    for (int i = 0; i < 20; ++i) a.in[i] = (const float*)d_in[i];
    a.out = (float*)d_out; a.ws = (unsigned char*)d_ws;
    if (N_LAUNCHES == 1) { a.ph_lo = 0; a.ph_hi = N_PHASES; hipLaunchKernelGGL(fwd_kernel, dim3(grid), dim3(NTHREADS), LDS_BYTES, stream, a); }
    else for (int p = 0; p < N_PHASES; ++p) { a.ph_lo = p; a.ph_hi = p + 1; hipLaunchKernelGGL(fwd_kernel, dim3(grid), dim3(NTHREADS), LDS_BYTES, stream, a); }
    const hipError_t le = hipPeekAtLastError();
    if (le != hipSuccess) fprintf(stderr, "kernel_launch: launch failed: %s\n", hipGetErrorName(le));
}
```

```cpp
#include <hip/hip_runtime.h>
#include <cstdio>
#include <cstdint>

#ifndef MK_N_LAUNCHES
#define MK_N_LAUNCHES 1
#endif

namespace pg8 {
#define PG8_LAS __attribute__((address_space(3)))
typedef unsigned short bf16_t;
typedef short bf16x8 __attribute__((ext_vector_type(8)));
typedef float f32x4 __attribute__((ext_vector_type(4)));
typedef unsigned u32x4 __attribute__((ext_vector_type(4)));
typedef int i32x4 __attribute__((ext_vector_type(4)));
typedef int i32x8 __attribute__((ext_vector_type(8)));
constexpr int BM = 256, BK = 64, HALF = 128, HTB = HALF * BK * 2  , STAGE_BYTES = 8 * HTB, NXCD = 8, WGM = 4;

__host__ __device__ __forceinline__ int lds_byte(int r, int c) { const int st = (r >> 4) * 2 + (c >> 5), rr = r & 15, cc = c & 31, ob = rr * 64 + cc * 2; return st * 1024 + (ob ^ (((ob >> 9) & 1) << 5)); }
__host__ __device__ __forceinline__ void stage_rc(int b, int& R, int& C) { const int st = b / 1024, sb = b % 1024, swz = sb ^ (((sb >> 9) & 1) << 5); R = (st >> 1) * 16 + swz / 64; C = (st & 1) * 32 + (swz % 64) / 2; }
__host__ __device__ __forceinline__ int perm32(int rho) { const int n = rho >> 4, i = rho & 15; return 8 * (i >> 2) + 4 * n + (i & 3); }

struct Unit { int pm, pn; };
struct Gemm { const bf16_t* A; const bf16_t* Bt; int M, N, K, lda, ldb, agrp, bgrp; };

struct StaticOrder {
    int nM, nN, nwg, G, c;
    __host__ __device__ void init(int M, int N, int G_, int c_) { nM = M / BM; nN = N / BM; nwg = nM * nN; G = G_; c = c_; }
    __host__ __device__ bool next(int i, Unit& u) const {
        const long L = (long)i * G + c; if (L >= nwg) return false;
        if (nM == 64 && (nN == 16 || nN == 32) && G % NXCD == 0) {
            const int xcd = (int)(L % NXCD), off = (int)(L / NXCD), xr = xcd >> 1, xc = xcd & 1, sg = off / (2 * nN), r = off % (2 * nN), ch = r >> 5, s = r & 31;
            u.pm = 16 * xr + 4 * sg + (s & 3); u.pn = xc * (nN >> 1) + ch * 8 + (s >> 2); return true;
        }
        int wgid = (int)L; { const int q = nwg / NXCD, r = nwg % NXCD, xcd = wgid % NXCD, off = wgid / NXCD; wgid = (xcd < r ? xcd * (q + 1) : r * (q + 1) + (xcd - r) * q) + off; }
        const int nig = WGM * nN, gid = wgid / nig, fm = gid * WGM, gsz = (nM - fm) < WGM ? (nM - fm) : WGM;
        u.pm = fm + ((wgid % nig) % gsz); u.pn = (wgid % nig) / gsz; return true;
    }
    __device__ __forceinline__ void a_ready(const Unit&) const {}
    __device__ __forceinline__ void done(const Unit&) const {}
};

struct MixedOrder {
    StaticOrder L, C; int G, c;
    __host__ __device__ void init(int G_, int c_) { G = G_; c = c_; L.init(8192, 13312, 1, 0); C.init(8192, 8192, 1, 0); }
    __host__ __device__ bool next(int i, Unit& u) const {
        int idx;
        if (G == 256) { if (i < 9) idx = i * 256 + c; else if (c < 128 && i < 12) idx = 2304 + (i - 9) * 128 + c; else return false; }
        else idx = i * G + c;
        if (idx < L.nwg) { L.next(idx, u); u.pm += 32; return true; }
        const int j = idx - L.nwg; if (j >= C.nwg) return false;
        C.next(j, u); u.pn = u.pn < 8 ? u.pn : (u.pn < 16 ? u.pn + 4 : u.pn + 20); return true;
    }
    __device__ __forceinline__ void a_ready(const Unit&) const {}
    __device__ __forceinline__ void done(const Unit&) const {}
};
__device__ __forceinline__ unsigned cvt_pk_bf16(float lo, float hi) { unsigned r; asm volatile("v_cvt_pk_bf16_f32 %0, %1, %2" : "=v"(r) : "v"(lo), "v"(hi)); return r; }
__device__ __forceinline__ float bf_lo(unsigned w) { return __uint_as_float(w << 16); }
__device__ __forceinline__ float bf_hi(unsigned w) { return __uint_as_float(w & 0xffff0000u); }
__device__ __forceinline__ float silu_f(float x) { return x * __builtin_amdgcn_rcpf(1.0f + __builtin_amdgcn_exp2f(-1.4426950408889634f * x)); }

struct EpiBf16 {
    static constexpr bool PERM = true, AFTER_DRAIN = false;
    bf16_t* O; int ldc; size_t bst; float mul;
    __device__ __forceinline__ void operator()(const f32x4 (&acc)[2][2][4][2], const Unit& u, int wr, int wc, int fr, int fq) const {
        const int row0 = u.pm * BM + wr * 64 + fr, col0 = wc * 32 + 8 * fq;
        bf16_t* Ot = O + (size_t)(2 * u.pn) * bst + col0;
#pragma unroll
        for (int ai = 0; ai < 2; ++ai)
#pragma unroll
            for (int m = 0; m < 4; ++m) { bf16_t* rowp = Ot + (size_t)(row0 + ai * HALF + m * 16) * ldc;
#pragma unroll
                for (int bj = 0; bj < 2; ++bj) { const f32x4 v0 = acc[ai][bj][m][0] * mul, v1 = acc[ai][bj][m][1] * mul;
                    u32x4 w; w.x = cvt_pk_bf16(v0[0], v0[1]); w.y = cvt_pk_bf16(v0[2], v0[3]); w.z = cvt_pk_bf16(v1[0], v1[1]); w.w = cvt_pk_bf16(v1[2], v1[3]);
                    *(u32x4*)(rowp + bj * bst) = w; } }
    }
};
constexpr int ROPE_LD = 36;
struct EpiQKVG {
    static constexpr bool PERM = true, AFTER_DRAIN = false;
    bf16_t* O; int ldc; size_t bst; float mul; const PG8_LAS float* tab;
    __device__ __forceinline__ void operator()(const f32x4 (&acc)[2][2][4][2], const Unit& u, int wr, int wc, int fr, int fq) const {
        const int row0 = u.pm * BM + wr * 64 + fr;
        if (u.pn >= 10) {
            bf16_t* Ot = O + (size_t)(2 * u.pn) * bst + wc * 32 + 8 * fq;
#pragma unroll
            for (int ai = 0; ai < 2; ++ai)
#pragma unroll
                for (int m = 0; m < 4; ++m) { bf16_t* rowp = Ot + (size_t)(row0 + ai * HALF + m * 16) * ldc;
#pragma unroll
                    for (int bj = 0; bj < 2; ++bj) { const f32x4 v0 = acc[ai][bj][m][0] * mul, v1 = acc[ai][bj][m][1] * mul;
                        u32x4 w; w.x = cvt_pk_bf16(v0[0], v0[1]); w.y = cvt_pk_bf16(v0[2], v0[3]); w.z = cvt_pk_bf16(v1[0], v1[1]); w.w = cvt_pk_bf16(v1[2], v1[3]);
                        *(u32x4*)(rowp + bj * bst) = w; } }
            return;
        }
        const bool rot = u.pm >= 32; const int blk = wc & 1, i0 = 8 * fq;
        bf16_t* Ot = O + (size_t)(2 * u.pn + (wc >> 1)) * bst + blk * 64 + i0;
        f32x4 c0 = (f32x4){mul, mul, mul, mul}, c1 = c0, s0 = (f32x4){0.f, 0.f, 0.f, 0.f}, s1 = s0;
#define PG8_ROPE_LOAD(pos) do { const PG8_LAS float* tp = tab + (pos) * ROPE_LD + i0; c0 = *(const PG8_LAS f32x4*)tp * mul; c1 = *(const PG8_LAS f32x4*)(tp + 4) * mul; \
            s0 = *(const PG8_LAS f32x4*)(tp + 64 * ROPE_LD) * mul; s1 = *(const PG8_LAS f32x4*)(tp + 64 * ROPE_LD + 4) * mul; } while (0)
#define PG8_ROPE_ROW(ai, m) do { const int row = row0 + (ai) * HALF + (m) * 16; \
            const f32x4 l0 = acc[ai][0][m][0], l1 = acc[ai][0][m][1], h0 = acc[ai][1][m][0], h1 = acc[ai][1][m][1]; \
            const f32x4 a0 = l0 * c0 - h0 * s0, a1 = l1 * c1 - h1 * s1, b0 = h0 * c0 + l0 * s0, b1 = h1 * c1 + l1 * s1; \
            u32x4 wa, wb; wa.x = cvt_pk_bf16(a0[0], a0[1]); wa.y = cvt_pk_bf16(a0[2], a0[3]); wa.z = cvt_pk_bf16(a1[0], a1[1]); wa.w = cvt_pk_bf16(a1[2], a1[3]); \
            wb.x = cvt_pk_bf16(b0[0], b0[1]); wb.y = cvt_pk_bf16(b0[2], b0[3]); wb.z = cvt_pk_bf16(b1[0], b1[1]); wb.w = cvt_pk_bf16(b1[2], b1[3]); \
            bf16_t* rowp = Ot + (size_t)row * ldc; *(u32x4*)rowp = wa; *(u32x4*)(rowp + 32) = wb; } while (0)
        if (!rot || blk == 0) {
#pragma unroll
            for (int ai = 0; ai < 2; ++ai) {
                if (rot) PG8_ROPE_LOAD(((row0 + ai * HALF) & 1023) >> 6);
#pragma unroll
                for (int m = 0; m < 4; ++m) PG8_ROPE_ROW(ai, m);
            }
        } else {
#pragma unroll
            for (int m = 0; m < 4; ++m) {
                PG8_ROPE_LOAD((row0 + m * 16) & 63);
#pragma unroll
                for (int ai = 0; ai < 2; ++ai) PG8_ROPE_ROW(ai, m);
            }
        }
#undef PG8_ROPE_LOAD
#undef PG8_ROPE_ROW
    }
};
struct EpiKV {
    static constexpr bool PERM = true, AFTER_DRAIN = false;
    bf16_t* O; int ldc; size_t bst; float* nak; float* nav; float* nbk; float* nbv;
    __device__ __forceinline__ void operator()(const f32x4 (&acc)[2][2][4][2], const Unit& u, int wr, int wc, int fr, int fq) const {
        const int pn = u.pn, colt = pn < 4 ? 2048 + 256 * pn : 5120 + 256 * (pn - 4);
        const int row0 = u.pm * BM + wr * 64 + fr, col0 = wc * 32 + 8 * fq;
        bf16_t* Ot = O + (size_t)(colt >> 7) * bst + col0;
        float* fdst; int fld;
        if (pn < 2)       { fdst = nak + pn * 256;        fld = 512; }
        else if (pn < 4)  { fdst = nav + (pn - 2) * 256;  fld = 512; }
        else if (pn < 12) { fdst = nbk + (pn - 4) * 256;  fld = 2048; }
        else              { fdst = nbv + (pn - 12) * 256; fld = 2048; }
#pragma unroll
        for (int ai = 0; ai < 2; ++ai)
#pragma unroll
            for (int m = 0; m < 4; ++m) { const int row = row0 + ai * HALF + m * 16; bf16_t* rowp = Ot + (size_t)row * ldc;
#pragma unroll
                for (int bj = 0; bj < 2; ++bj) { const f32x4 v0 = acc[ai][bj][m][0], v1 = acc[ai][bj][m][1];
                    u32x4 w; w.x = cvt_pk_bf16(v0[0], v0[1]); w.y = cvt_pk_bf16(v0[2], v0[3]); w.z = cvt_pk_bf16(v1[0], v1[1]); w.w = cvt_pk_bf16(v1[2], v1[3]);
                    *(u32x4*)(rowp + bj * bst) = w;
                    float* fp = fdst + (size_t)row * fld + wc * 32 + 8 * fq + bj * HALF; *(f32x4*)fp = v0; *(f32x4*)(fp + 4) = v1; } }
    }
};
template <class TB, class TO, bool I8> struct EpiResT {
    static constexpr bool PERM = true, AFTER_DRAIN = false;
    const TB* baseP; const TB* baseS; TO* out; int ldc; const float* gate; float mul; const float* sa; const float* sb;
    __device__ __forceinline__ void operator()(const f32x4 (&acc)[2][2][4][2], const Unit& u, int wr, int wc, int fr, int fq) const {
        const int row0 = u.pm * BM + wr * 64 + fr, col0 = u.pn * BM + wc * 32 + 8 * fq;
        const int j = u.pm < 32 ? 0 : 1 + ((u.pm - 32) >> 2);
        const float* gv = gate + (size_t)j * 12288 + col0;
        const TB* bp = u.pm < 32 ? baseP + (size_t)row0 * ldc : baseS + (size_t)(row0 - 8192) * ldc;
        f32x4 g4[2][2];
#pragma unroll
        for (int bj = 0; bj < 2; ++bj)
#pragma unroll
            for (int n = 0; n < 2; ++n) { g4[bj][n] = *(const f32x4*)(gv + bj * HALF + 4 * n); if constexpr (I8) g4[bj][n] = g4[bj][n] * *(const f32x4*)(sb + col0 + bj * HALF + 4 * n); else g4[bj][n] = g4[bj][n] * mul; }
#pragma unroll
        for (int ai = 0; ai < 2; ++ai)
#pragma unroll
            for (int m = 0; m < 4; ++m) { const size_t ro = (size_t)(ai * HALF + m * 16) * ldc + col0; TO* op = out + (size_t)row0 * ldc + ro; const TB* ip = bp + ro;
                float sr = 1.0f; if constexpr (I8) sr = sa[row0 + ai * HALF + m * 16];
#pragma unroll
                for (int bj = 0; bj < 2; ++bj) { f32x4 b0, b1;
                    if constexpr (sizeof(TB) == 4) { b0 = *(const f32x4*)(ip + bj * HALF); b1 = *(const f32x4*)(ip + bj * HALF + 4); }
                    else { const u32x4 w = *(const u32x4*)(ip + bj * HALF); b0 = (f32x4){bf_lo(w.x), bf_hi(w.x), bf_lo(w.y), bf_hi(w.y)}; b1 = (f32x4){bf_lo(w.z), bf_hi(w.z), bf_lo(w.w), bf_hi(w.w)}; }
                    f32x4 a0, a1;
                    if constexpr (I8) { a0 = __builtin_convertvector(__builtin_bit_cast(i32x4, acc[ai][bj][m][0]), f32x4) * sr; a1 = __builtin_convertvector(__builtin_bit_cast(i32x4, acc[ai][bj][m][1]), f32x4) * sr; }
                    else { a0 = acc[ai][bj][m][0]; a1 = acc[ai][bj][m][1]; }
                    const f32x4 v0 = b0 + g4[bj][0] * a0, v1 = b1 + g4[bj][1] * a1;
                    if constexpr (sizeof(TO) == 4) { *(f32x4*)(op + bj * HALF) = v0; *(f32x4*)(op + bj * HALF + 4) = v1; }
                    else { u32x4 w; w.x = cvt_pk_bf16(v0[0], v0[1]); w.y = cvt_pk_bf16(v0[2], v0[3]); w.z = cvt_pk_bf16(v1[0], v1[1]); w.w = cvt_pk_bf16(v1[2], v1[3]); *(u32x4*)(op + bj * HALF) = w; } }
                asm volatile("" ::: "memory"); }
    }
};
struct EpiPool {
    static constexpr bool PERM = true, AFTER_DRAIN = false;
    bf16_t* O; int ldc; const bf16_t* G; int ldg; const float* scale;
    __device__ __forceinline__ void operator()(const f32x4 (&acc)[2][2][4][2], const Unit& u, int wr, int wc, int fr, int fq) const {
        const int row0 = u.pm * BM + wr * 64 + fr, col0 = u.pn * BM + wc * 32 + 8 * fq;
        f32x4 sc[2][2];
#pragma unroll
        for (int bj = 0; bj < 2; ++bj)
#pragma unroll
            for (int n = 0; n < 2; ++n) sc[bj][n] = *(const f32x4*)(scale + col0 + bj * HALF + 4 * n);
#pragma unroll
        for (int ai = 0; ai < 2; ++ai)
#pragma unroll
            for (int m = 0; m < 4; ++m) { const int row = row0 + ai * HALF + m * 16; bf16_t* rowp = O + (size_t)row * ldc + col0; const bf16_t* gp = G + (size_t)row * ldg + col0;
#pragma unroll
                for (int bj = 0; bj < 2; ++bj) { const u32x4 gw = *(const u32x4*)(gp + bj * HALF);
                    f32x4 v0 = acc[ai][bj][m][0] * sc[bj][0], v1 = acc[ai][bj][m][1] * sc[bj][1];
                    v0[0] *= silu_f(bf_lo(gw.x)); v0[1] *= silu_f(bf_hi(gw.x)); v0[2] *= silu_f(bf_lo(gw.y)); v0[3] *= silu_f(bf_hi(gw.y));
                    v1[0] *= silu_f(bf_lo(gw.z)); v1[1] *= silu_f(bf_hi(gw.z)); v1[2] *= silu_f(bf_lo(gw.w)); v1[3] *= silu_f(bf_hi(gw.w));
                    u32x4 w; w.x = cvt_pk_bf16(v0[0], v0[1]); w.y = cvt_pk_bf16(v0[2], v0[3]); w.z = cvt_pk_bf16(v1[0], v1[1]); w.w = cvt_pk_bf16(v1[2], v1[3]);
                    *(u32x4*)(rowp + bj * HALF) = w; }
                asm volatile("" ::: "memory"); }
    }
};
struct EpiI8 {
    static constexpr bool PERM = true, AFTER_DRAIN = false;
    bf16_t* O; int ldc; const float* sa; const float* sb;
    __device__ __forceinline__ void operator()(const f32x4 (&acc)[2][2][4][2], const Unit& u, int wr, int wc, int fr, int fq) const {
        const int row0 = u.pm * BM + wr * 64 + fr, col0 = u.pn * BM + wc * 32 + 8 * fq;
        f32x4 sc[2][2];
#pragma unroll
        for (int bj = 0; bj < 2; ++bj)
#pragma unroll
            for (int n = 0; n < 2; ++n) sc[bj][n] = *(const f32x4*)(sb + col0 + bj * HALF + 4 * n);
#pragma unroll
        for (int ai = 0; ai < 2; ++ai)
#pragma unroll
            for (int m = 0; m < 4; ++m) { const int row = row0 + ai * HALF + m * 16; const float sr = sa[row]; bf16_t* rowp = O + (size_t)row * ldc + col0;
#pragma unroll
                for (int bj = 0; bj < 2; ++bj) { const i32x4 i0 = __builtin_bit_cast(i32x4, acc[ai][bj][m][0]), i1 = __builtin_bit_cast(i32x4, acc[ai][bj][m][1]);
                    const f32x4 v0 = __builtin_convertvector(i0, f32x4) * sc[bj][0] * sr, v1 = __builtin_convertvector(i1, f32x4) * sc[bj][1] * sr;
                    u32x4 w; w.x = cvt_pk_bf16(v0[0], v0[1]); w.y = cvt_pk_bf16(v0[2], v0[3]); w.z = cvt_pk_bf16(v1[0], v1[1]); w.w = cvt_pk_bf16(v1[2], v1[3]);
                    *(u32x4*)(rowp + bj * HALF) = w; } }
    }
};
template <class Epi, class Sched, bool ALIGN_EPI = false, bool SP2 = false, int MODE = 0>
__device__ __forceinline__ void gemm_phase(PG8_LAS unsigned char* lds, const Gemm g, const Sched& S, const Epi& E) {
    const int tid = threadIdx.x, wid = __builtin_amdgcn_readfirstlane(tid >> 6), lane = tid & 63, wr = wid >> 2, wc = wid & 3, fr = lane & 15, fq = lane >> 4;
    constexpr bool F8 = MODE == 1, I8 = MODE == 2; constexpr int ES = MODE ? 1 : 2; const int K = g.K, nt = K * ES / (BK * 2);
    unsigned voffA[2], voffB[2];
#pragma unroll
    for (int i = 0; i < 2; ++i) { int R, C; stage_rc(tid * 16 + i * 8192, R, C); const int Rb = Epi::PERM ? ((R & ~31) + perm32(R & 31)) : R;
        voffA[i] = (unsigned)(R * g.lda * ES + C * 2); voffB[i] = (unsigned)(Rb * g.ldb * ES + C * 2); }
    const size_t kstep = (size_t)(BK * 2);
    const size_t hstepA = (size_t)HALF * g.lda * ES, hstepB = (size_t)HALF * g.ldb * ES;
    const size_t tstepA = 2 * hstepA, tstepB = 2 * hstepB;
    const unsigned ldsw = (unsigned)wid * 1024u;
    const int aoff = lds_byte(wr * 64 + fr, fq * 8), boff = lds_byte(wc * 32 + fr, fq * 8);
#define PG8_SA(b, h) (((b) * 2 + (h)) * HTB)
#define PG8_SB(b, h) ((4 + (b) * 2 + (h)) * HTB)
#define PG8_STAGE(bufoff, gbase, voff) do { _Pragma("unroll") for (int _i = 0; _i < 2; ++_i) \
        __builtin_amdgcn_global_load_lds((const unsigned*)((const char*)(gbase) + (voff)[_i]), (PG8_LAS unsigned*)(lds + (bufoff) + ldsw + _i * 8192), 16, 0, 0); } while (0)
#define PG8_LDA(dst, b, h) do { _Pragma("unroll") for (int m = 0; m < 4; ++m) { if constexpr (F8) dst##8[m] = PG8_CAT(*(const PG8_LAS bf16x8*)(lds + PG8_SA(b, h) + aoff + m * 2048), *(const PG8_LAS bf16x8*)(lds + PG8_SA(b, h) + aoff + m * 2048 + 1024)); \
        else { _Pragma("unroll") for (int k = 0; k < 2; ++k) dst[m][k] = *(const PG8_LAS bf16x8*)(lds + PG8_SA(b, h) + aoff + m * 2048 + k * 1024); } } } while (0)
#define PG8_LDB(dst, b, h) do { _Pragma("unroll") for (int n = 0; n < 2; ++n) { if constexpr (F8) dst##8[n] = PG8_CAT(*(const PG8_LAS bf16x8*)(lds + PG8_SB(b, h) + boff + n * 2048), *(const PG8_LAS bf16x8*)(lds + PG8_SB(b, h) + boff + n * 2048 + 1024)); \
        else { _Pragma("unroll") for (int k = 0; k < 2; ++k) dst[n][k] = *(const PG8_LAS bf16x8*)(lds + PG8_SB(b, h) + boff + n * 2048 + k * 1024); } } } while (0)
#define PG8_MMA(ai, bj, At, Bt) do { __builtin_amdgcn_s_setprio(1); _Pragma("unroll") for (int m = 0; m < 4; ++m) _Pragma("unroll") for (int n = 0; n < 2; ++n) { \
        if constexpr (F8) asm volatile("v_mfma_scale_f32_16x16x128_f8f6f4 %0, %1, %2, %0, %3, %3 op_sel_hi:[0,0,0]" : "+v"(acc[ai][bj][m][n]) : "v"(Bt##8[n]), "v"(At##8[m]), "v"(sc1)); \
        else if constexpr (I8) { _Pragma("unroll") for (int k = 0; k < 2; ++k) acc[ai][bj][m][n] = __builtin_bit_cast(f32x4, __builtin_amdgcn_mfma_i32_16x16x64_i8(__builtin_bit_cast(i32x4, Bt[n][k]), __builtin_bit_cast(i32x4, At[m][k]), __builtin_bit_cast(i32x4, acc[ai][bj][m][n]), 0, 0, 0)); } \
        else { _Pragma("unroll") for (int k = 0; k < 2; ++k) acc[ai][bj][m][n] = __builtin_amdgcn_mfma_f32_16x16x32_bf16(Bt[n][k], At[m][k], acc[ai][bj][m][n], 0, 0, 0); } } \
        __builtin_amdgcn_s_setprio(0); } while (0)
#define PG8_CAT(lo, hi) __builtin_shufflevector(__builtin_bit_cast(i32x4, lo), __builtin_bit_cast(i32x4, hi), 0, 1, 2, 3, 4, 5, 6, 7)
#define PG8_WAIT_V(n) asm volatile("s_waitcnt vmcnt(" #n ")" ::: "memory")
#define PG8_WAIT_L(n) asm volatile("s_waitcnt lgkmcnt(" #n ")" ::: "memory")
#define PG8_BAR __builtin_amdgcn_s_barrier()
#define PG8_SCHED __builtin_amdgcn_sched_barrier(0)
    Unit cur, nxt; int ui = 0;
    if (!S.next(0, cur)) return;
    f32x4 acc[2][2][4][2];
#pragma unroll
    for (int a = 0; a < 2; ++a)
#pragma unroll
        for (int b = 0; b < 2; ++b)
#pragma unroll
            for (int m = 0; m < 4; ++m)
#pragma unroll
                for (int n = 0; n < 2; ++n) acc[a][b][m][n] = (f32x4){0.f, 0.f, 0.f, 0.f};
    int sc1 = 0x7F7F7F7F; asm volatile("" : "+v"(sc1));
    bf16x8 At[4][2], B0[2][2], B1[2][2]; i32x8 At8[4], B08[2], B18[2];
    const char* cA = (const char*)g.A + (size_t)cur.pm * tstepA + (g.agrp ? (size_t)(cur.pn / g.agrp) * K * ES : (size_t)0); const char* cB = (const char*)g.Bt + (size_t)cur.pn * tstepB + (g.bgrp ? (size_t)(cur.pm / g.bgrp) * K * ES : (size_t)0);
    S.a_ready(cur);
    if constexpr (SP2) {
        PG8_STAGE(PG8_SB(0, 0), cB, voffB); PG8_STAGE(PG8_SB(0, 1), cB + hstepB, voffB); PG8_STAGE(PG8_SA(0, 0), cA, voffA); PG8_STAGE(PG8_SA(0, 1), cA + hstepA, voffA);
        if (wr == 1) PG8_BAR;
        PG8_WAIT_V(2); PG8_BAR;
        PG8_STAGE(PG8_SB(1, 0), cB + kstep, voffB); PG8_STAGE(PG8_SA(1, 0), cA + kstep, voffA); PG8_STAGE(PG8_SB(1, 1), cB + hstepB + kstep, voffB);
        PG8_WAIT_V(6); PG8_BAR;
    } else {
        PG8_STAGE(PG8_SB(0, 0), cB, voffB); PG8_STAGE(PG8_SA(0, 0), cA, voffA); PG8_STAGE(PG8_SB(0, 1), cB + hstepB, voffB); PG8_STAGE(PG8_SA(0, 1), cA + hstepA, voffA);
        if (wr == 1) PG8_BAR;
        PG8_WAIT_V(4); PG8_BAR;
        PG8_STAGE(PG8_SB(1, 0), cB + kstep, voffB); PG8_STAGE(PG8_SA(1, 0), cA + kstep, voffA); PG8_STAGE(PG8_SB(1, 1), cB + hstepB + kstep, voffB);
        PG8_WAIT_V(6); PG8_BAR;
    }
    for (;;) {
        const bool has_next = S.next(ui + 1, nxt);
        const char* nA = has_next ? (const char*)g.A + (size_t)nxt.pm * tstepA + (g.agrp ? (size_t)(nxt.pn / g.agrp) * K * ES : (size_t)0) : cA; const char* nB = has_next ? (const char*)g.Bt + (size_t)nxt.pn * tstepB + (g.bgrp ? (size_t)(nxt.pm / g.bgrp) * K * ES : (size_t)0) : cB;
        for (int t = 0; t < nt; t += 2) {
            const bool last = (t == nt - 2);
            const char* a1 = cA + (size_t)(t + 1) * kstep;
            const char* a2 = last ? nA : cA + (size_t)(t + 2) * kstep; const char* b2 = last ? nB : cB + (size_t)(t + 2) * kstep;
            const char* a3 = a2 + kstep; const char* b3 = b2 + kstep;
            if (last && has_next) S.a_ready(nxt);
            if constexpr (SP2) {
            PG8_LDB(B0, 0, 0); PG8_LDB(B1, 0, 1); PG8_SCHED; PG8_LDA(At, 0, 0); PG8_STAGE(PG8_SA(1, 1), a1 + hstepA, voffA);
            PG8_WAIT_V(8); PG8_WAIT_L(0); PG8_BAR; PG8_MMA(0, 0, At, B0); PG8_MMA(0, 1, At, B1); PG8_BAR; PG8_SCHED;
            PG8_LDA(At, 0, 1); PG8_STAGE(PG8_SB(0, 0), b2, voffB); PG8_STAGE(PG8_SB(0, 1), b2 + hstepB, voffB); PG8_STAGE(PG8_SA(0, 0), a2, voffA);
            PG8_WAIT_V(8); PG8_WAIT_L(0); PG8_BAR; PG8_MMA(1, 0, At, B0); PG8_MMA(1, 1, At, B1); PG8_BAR; PG8_SCHED;
            PG8_LDB(B0, 1, 0); PG8_LDB(B1, 1, 1); PG8_SCHED; PG8_LDA(At, 1, 0); PG8_STAGE(PG8_SA(0, 1), a2 + hstepA, voffA);
            PG8_WAIT_V(8); PG8_WAIT_L(0); PG8_BAR; PG8_MMA(0, 0, At, B0); PG8_MMA(0, 1, At, B1); PG8_BAR; PG8_SCHED;
            PG8_LDA(At, 1, 1); PG8_STAGE(PG8_SB(1, 0), b3, voffB); PG8_STAGE(PG8_SB(1, 1), b3 + hstepB, voffB); PG8_STAGE(PG8_SA(1, 0), a3, voffA);
            PG8_WAIT_V(8); PG8_WAIT_L(0); PG8_BAR; PG8_MMA(1, 0, At, B0); PG8_MMA(1, 1, At, B1); PG8_BAR; PG8_SCHED;
            } else {
            PG8_LDB(B0, 0, 0); PG8_SCHED; PG8_LDA(At, 0, 0); PG8_STAGE(PG8_SA(1, 1), a1 + hstepA, voffA);
            PG8_WAIT_L(8); PG8_BAR; PG8_WAIT_L(0); PG8_MMA(0, 0, At, B0); PG8_BAR; PG8_SCHED;
            PG8_LDB(B1, 0, 1); PG8_STAGE(PG8_SB(0, 0), b2, voffB);
            PG8_BAR; PG8_WAIT_L(0); PG8_MMA(0, 1, At, B1); PG8_BAR;
            PG8_LDA(At, 0, 1); PG8_STAGE(PG8_SA(0, 0), a2, voffA);
            PG8_BAR; PG8_WAIT_L(0); PG8_MMA(1, 0, At, B0); PG8_BAR; PG8_SCHED;
            PG8_STAGE(PG8_SB(0, 1), b2 + hstepB, voffB);
            PG8_WAIT_V(6); PG8_BAR; PG8_MMA(1, 1, At, B1); PG8_BAR;
            PG8_LDB(B0, 1, 0); PG8_SCHED; PG8_LDA(At, 1, 0); PG8_STAGE(PG8_SA(0, 1), a2 + hstepA, voffA);
            PG8_WAIT_L(8); PG8_BAR; PG8_WAIT_L(0); PG8_MMA(0, 0, At, B0); PG8_BAR; PG8_SCHED;
            PG8_LDB(B1, 1, 1); PG8_STAGE(PG8_SB(1, 0), b3, voffB);
            PG8_BAR; PG8_WAIT_L(0); PG8_MMA(0, 1, At, B1); PG8_BAR;
            PG8_LDA(At, 1, 1); PG8_STAGE(PG8_SA(1, 0), a3, voffA);
            PG8_BAR; PG8_WAIT_L(0); PG8_MMA(1, 0, At, B0); PG8_BAR; PG8_SCHED;
            PG8_STAGE(PG8_SB(1, 1), b3 + hstepB, voffB);
            PG8_WAIT_V(6); PG8_BAR; PG8_MMA(1, 1, At, B1); PG8_BAR;
            }
        }
        if constexpr (ALIGN_EPI) { if (wr == 0) PG8_BAR; }
        if constexpr (F8) asm volatile("s_nop 15\n\ts_nop 15" ::: "memory");
        if constexpr (!Epi::AFTER_DRAIN) { E(acc, cur, wr, wc, fr, fq); S.done(cur); }
        if (!has_next) break;
#pragma unroll
        for (int a = 0; a < 2; ++a)
#pragma unroll
            for (int b = 0; b < 2; ++b)
#pragma unroll
                for (int m = 0; m < 4; ++m)
#pragma unroll
                    for (int n = 0; n < 2; ++n) acc[a][b][m][n] = (f32x4){0.f, 0.f, 0.f, 0.f};
        cur = nxt; cA = nA; cB = nB; ++ui;
        if constexpr (ALIGN_EPI) { if (wr == 1) PG8_BAR; }
    }
    PG8_WAIT_V(0);
    if constexpr (!ALIGN_EPI) { if (wr == 0) PG8_BAR; }
    PG8_BAR;
    if constexpr (Epi::AFTER_DRAIN) { E.fused(acc, cur, wr, wc, fr, fq, lds, wid, lane); S.done(cur); }
#undef PG8_SA
#undef PG8_SB
#undef PG8_STAGE
#undef PG8_LDA
#undef PG8_LDB
#undef PG8_MMA
#undef PG8_CAT
#undef PG8_WAIT_V
#undef PG8_WAIT_L
#undef PG8_BAR
#undef PG8_SCHED
}
}

namespace att {
typedef unsigned short bf16;
using bf16x8 = __attribute__((ext_vector_type(8))) short;
using s16x4  = __attribute__((ext_vector_type(4))) short;
using f32x16 = __attribute__((ext_vector_type(16))) float;
using u32x4  = __attribute__((ext_vector_type(4))) unsigned;
constexpr int HD_ = 128, NW = 8, QBLK = 32, KVBLK = 64, LDQ = 128  , LDO = 4096 + 128;
constexpr float SCALE = 0.088388347648318440f, INV_SCALE = 11.313708498984761f, THR = 8.f, NEG = -1e30f;
constexpr size_t SHM_V = KVBLK * HD_ * 2, SHM_K = KVBLK * HD_ * 2, OFF_WS = 2 * SHM_V + 2 * SHM_K, OFF_RPB = OFF_WS + NW * 64 * 4, OFF_STG = OFF_RPB + 3072, OFF_SINK = OFF_STG + NW * 32 * 272, SHM_ATTN = OFF_SINK + 64;
constexpr int STG_ROW = 272, STG_WAVE = 32 * STG_ROW, YST_ROW = 144;
#define KSWZ(row, colB) ((row) * 256 + ((colB) ^ (((row) & 7) << 4)))
#define SBAR() __builtin_amdgcn_sched_barrier(0)
__device__ __forceinline__ int crow(int r, int hi) { return (r & 3) + 8 * (r >> 2) + 4 * hi; }
__device__ __forceinline__ unsigned cvtpk(float lo, float hi) { unsigned r; asm volatile("v_cvt_pk_bf16_f32 %0, %1, %2" : "=v"(r) : "v"(lo), "v"(hi)); return r; }

struct Unit {
    const bf16* q;
    const bf16* kc; const bf16* vc; int nctx;
    const bf16* kl; const bf16* vl;
    int nt;
    int mask;
    int qpos0, kpos0;
    int has_sink, sink_i;
    const float* rpb;
    const bf16* gate; unsigned char* out;
};

__device__ __forceinline__ void partialSM(f32x16& p0, f32x16& p1, float& m_reg, float& mn, float& alpha) {
    constexpr float C = SCALE * 1.4426950408889634f;
    float pmax = p0[0];
#pragma unroll
    for (int r = 1; r < 16; ++r) pmax = fmaxf(pmax, p0[r]);
#pragma unroll
    for (int r = 0; r < 16; ++r) pmax = fmaxf(pmax, p1[r]);
    { auto rr = __builtin_amdgcn_permlane32_swap(__float_as_uint(pmax), __float_as_uint(pmax), false, false);
      pmax = fmaxf(__uint_as_float(rr[0]), __uint_as_float(rr[1])); }
    if (__builtin_expect(__all(pmax - m_reg <= THR / SCALE), 1)) { mn = m_reg; alpha = 1.f; }
    else { mn = fmaxf(m_reg, pmax); alpha = __builtin_amdgcn_exp2f((m_reg - mn) * C); m_reg = mn; }
    const float mnC = -mn * C;
#pragma unroll
    for (int r = 0; r < 16; ++r) p0[r] = fmaf(p0[r], C, mnC);
#pragma unroll
    for (int r = 0; r < 16; ++r) p1[r] = fmaf(p1[r], C, mnC);
#pragma unroll
    for (int r = 0; r < 16; ++r) p0[r] = __builtin_amdgcn_exp2f(p0[r]);
}
__device__ __forceinline__ void finishSM(f32x16& p0, f32x16& p1, float alpha, float& l_reg, bf16x8& pa0, bf16x8& pa1, bf16x8& pa2, bf16x8& pa3) {
#pragma unroll
    for (int r = 0; r < 16; ++r) p1[r] = __builtin_amdgcn_exp2f(p1[r]);
    float ps = 0;
#pragma unroll
    for (int r = 0; r < 16; ++r) ps += p0[r];
#pragma unroll
    for (int r = 0; r < 16; ++r) ps += p1[r];
    { auto rr = __builtin_amdgcn_permlane32_swap(__float_as_uint(ps), __float_as_uint(ps), false, false);
      ps = __uint_as_float(rr[0]) + __uint_as_float(rr[1]); }
    l_reg = l_reg * alpha + ps;
#define ATT_PK4(P, BASE, OUT) do { unsigned a0 = cvtpk(P[BASE + 0], P[BASE + 1]), a1 = cvtpk(P[BASE + 2], P[BASE + 3]);   \
    unsigned b0 = cvtpk(P[BASE + 4], P[BASE + 5]), b1 = cvtpk(P[BASE + 6], P[BASE + 7]);                              \
    auto r0 = __builtin_amdgcn_permlane32_swap(a0, b0, false, false); auto r1 = __builtin_amdgcn_permlane32_swap(a1, b1, false, false); \
    u32x4 w = {r0[0], r1[0], r0[1], r1[1]}; OUT = *reinterpret_cast<bf16x8*>(&w); } while (0)
    ATT_PK4(p0, 0, pa0); ATT_PK4(p0, 8, pa1); ATT_PK4(p1, 0, pa2); ATT_PK4(p1, 8, pa3);
#undef ATT_PK4
}
__device__ __forceinline__ void qkt(f32x16& p0, f32x16& p1, const char* Ks, const bf16x8* qr, int r32, int hi) {
    p0 = f32x16{}; p1 = f32x16{};
#pragma unroll
    for (int d0 = 0; d0 < 8; ++d0) { const int cb = (d0 * 16 + hi * 8) * 2;
        const bf16x8 b0 = *reinterpret_cast<const bf16x8*>(Ks + KSWZ(r32, cb));
        const bf16x8 b1 = *reinterpret_cast<const bf16x8*>(Ks + KSWZ(32 + r32, cb));
        p0 = __builtin_amdgcn_mfma_f32_32x32x16_bf16(b0, qr[d0], p0, 0, 0, 0);
        p1 = __builtin_amdgcn_mfma_f32_32x32x16_bf16(b1, qr[d0], p1, 0, 0, 0); }
}
__device__ __forceinline__ int v_st(int k, int c) { const int kk = (k & ~0xC) | ((k & 4) << 1) | ((k & 8) >> 1); return ((kk >> 3) * 4 + (c >> 5)) * 512 + ((kk & 7) * 32 + (c & 31)) * 2; }
__device__ __forceinline__ int v_rd_base(int lane) { return ((lane & 3) << 3) | (((lane >> 2) & 3) << 6) | (((lane >> 4) & 1) << 5) | (((lane >> 5) & 1) << 8); }
constexpr int v_rd_off(int d0, int ks, int half) { return d0 * 512 + ks * 4096 + half * 2048; }
template <int OFF> __device__ __forceinline__ s16x4 tr_read(int vb) {
    s16x4 r; asm volatile("ds_read_b64_tr_b16 %0, %1 offset:%2" : "=&v"(r) : "v"(vb), "i"(OFF) : "memory"); return r;
}
template <int D0> __device__ __forceinline__ void pv_one(f32x16& od, int vb, bf16x8 pa0, bf16x8 pa1, bf16x8 pa2, bf16x8 pa3) {
    const s16x4 l0 = tr_read<v_rd_off(D0, 0, 0)>(vb), h0 = tr_read<v_rd_off(D0, 0, 1)>(vb), l1 = tr_read<v_rd_off(D0, 1, 0)>(vb), h1 = tr_read<v_rd_off(D0, 1, 1)>(vb);
    const s16x4 l2 = tr_read<v_rd_off(D0, 2, 0)>(vb), h2 = tr_read<v_rd_off(D0, 2, 1)>(vb), l3 = tr_read<v_rd_off(D0, 3, 0)>(vb), h3 = tr_read<v_rd_off(D0, 3, 1)>(vb);
    asm volatile("s_waitcnt lgkmcnt(0)" ::: "memory"); SBAR();
#define ATT_PK(L, H) (bf16x8){L[0], L[1], L[2], L[3], H[0], H[1], H[2], H[3]}
    od = __builtin_amdgcn_mfma_f32_32x32x16_bf16(ATT_PK(l0, h0), pa0, od, 0, 0, 0);
    od = __builtin_amdgcn_mfma_f32_32x32x16_bf16(ATT_PK(l1, h1), pa1, od, 0, 0, 0);
    od = __builtin_amdgcn_mfma_f32_32x32x16_bf16(ATT_PK(l2, h2), pa2, od, 0, 0, 0);
    od = __builtin_amdgcn_mfma_f32_32x32x16_bf16(ATT_PK(l3, h3), pa3, od, 0, 0, 0);
#undef ATT_PK
}
__device__ __forceinline__ void pv_d0(f32x16* o, int vb, bf16x8 pa0, bf16x8 pa1, bf16x8 pa2, bf16x8 pa3) {
    pv_one<0>(o[0], vb, pa0, pa1, pa2, pa3); pv_one<1>(o[1], vb, pa0, pa1, pa2, pa3); pv_one<2>(o[2], vb, pa0, pa1, pa2, pa3); pv_one<3>(o[3], vb, pa0, pa1, pa2, pa3);
}
__device__ __forceinline__ void apply_mask(f32x16& p0, f32x16& p1, const Unit& u, int j, int wid, int r32, int hi, const float* rpb_l) {
    if (u.mask == 0 || j < u.nctx) return;
    const int jl = j - u.nctx;
    asm volatile("" : "+v"(r32), "+v"(hi));
    if (u.mask == 1) {
        const int qw0 = u.qpos0 + wid * QBLK, k0 = u.kpos0 + jl * KVBLK;
        if (qw0 + 31 - k0 <= 128 && k0 + 63 - qw0 <= 128) return;
        if (qw0 - (k0 + 63) > 128 || k0 - (qw0 + 31) > 128) {
#pragma unroll
            for (int r = 0; r < 16; ++r) { p0[r] = NEG; p1[r] = NEG; }
            return; }
        const int dl = qw0 + r32 - k0 - 4 * hi + 128;
#pragma unroll
        for (int r = 0; r < 16; ++r) { const int kc0 = (r & 3) + 8 * (r >> 2);
            p0[r] = (unsigned)(dl - kc0) > 256u ? NEG : p0[r]; p1[r] = (unsigned)(dl - kc0 - 32) > 256u ? NEG : p1[r]; }
    } else {
        const int rq = u.qpos0 + (wid >> 1), kr = u.kpos0 + jl;
        const int rs = rq - 4 < 0 ? 0 : (rq - 4 > 8 ? 8 : rq - 4);
        if (kr < rs || kr >= rs + 8) {
#pragma unroll
            for (int r = 0; r < 16; ++r) { p0[r] = NEG; p1[r] = NEG; }
            return; }
        const int c = (wid & 1) * 32 + r32, cs = c - 8 < 0 ? 0 : (c - 8 > 48 ? 48 : c - 8);
        const int lv = 4 * hi - cs;
        const float* tb = rpb_l + (kr - rq + 7) * 31 + (4 * hi - c + 15);
#pragma unroll
        for (int rg = 0; rg < 16; rg += 4) {
            float b0[4], b1[4];
#pragma unroll
            for (int e = 0; e < 4; ++e) { const int kc0 = ((rg + e) & 3) + 8 * ((rg + e) >> 2); b0[e] = tb[kc0]; b1[e] = tb[kc0 + 32]; }
#pragma unroll
            for (int e = 0; e < 4; ++e) { const int r = rg + e, kc0 = (r & 3) + 8 * (r >> 2);
                p0[r] = (unsigned)(kc0 + lv) < 16u ? p0[r] + b0[e] : NEG; p1[r] = (unsigned)(kc0 + 32 + lv) < 16u ? p1[r] + b1[e] : NEG; }
        }
    }
}

struct Regs { bf16x8 qr[8]; bf16x8 vs0[2], vs1[2], ks0[2], ks1[2]; float rpbv; u32x4 w[4]; unsigned char* wp; };
__device__ __forceinline__ void attn_flush(Regs& R) {
#pragma unroll
    for (int i = 0; i < 4; ++i) *reinterpret_cast<u32x4*>(R.wp + (size_t)i * 8 * LDO) = R.w[i];
}
template <int I> __device__ __forceinline__ void sload(const Unit& u, Regs& R, int j, int sr, int sc) {
    const bf16* kt_; const bf16* vt_; constexpr int ld_ = LDQ;
    if (j < u.nctx) { kt_ = u.kc + (size_t)j * KVBLK * LDQ; vt_ = u.vc + (size_t)j * KVBLK * LDQ; }
    else { kt_ = u.kl + (size_t)(j - u.nctx) * KVBLK * LDQ; vt_ = u.vl + (size_t)(j - u.nctx) * KVBLK * LDQ; }
    R.vs0[I] = *reinterpret_cast<const bf16x8*>(vt_ + (size_t)sr * ld_ + sc); R.vs1[I] = *reinterpret_cast<const bf16x8*>(vt_ + (size_t)(32 + sr) * ld_ + sc);
    R.ks0[I] = *reinterpret_cast<const bf16x8*>(kt_ + (size_t)sr * ld_ + sc); R.ks1[I] = *reinterpret_cast<const bf16x8*>(kt_ + (size_t)(32 + sr) * ld_ + sc);
}
__device__ __forceinline__ void attn_prefetch(const Unit& u, Regs& R) {
    int tid = threadIdx.x; asm volatile("" : "+v"(tid));
    const int wid = __builtin_amdgcn_readfirstlane(tid >> 6), lane = tid & 63, r32 = lane & 31, hi = lane >> 5, sr = tid >> 4, sc = (tid & 15) * 8;
    const bf16* Qw = u.q + (size_t)(wid * QBLK + r32) * LDQ + hi * 8;
#pragma unroll
    for (int d0 = 0; d0 < 8; ++d0) R.qr[d0] = *reinterpret_cast<const bf16x8*>(Qw + d0 * 16);
    sload<0>(u, R, 0, sr, sc); sload<1>(u, R, 1, sr, sc);
    R.rpbv = u.rpb[tid < 15 * 31 ? tid : 0];
}
__device__ __forceinline__ void attn_unit(const Unit& u, bool has_next, const Unit& nu, Regs& R, char* lds, bool has_prev) {
    int tid = threadIdx.x; asm volatile("" : "+v"(tid));
    const int wid = __builtin_amdgcn_readfirstlane(tid >> 6), lane = tid & 63, r32 = lane & 31, hi = lane >> 5;
    char* V_lds = lds; char* K_lds = lds + 2 * SHM_V;
    float* rpb_l = (float*)(lds + OFF_RPB + 256);
    if (u.mask == 2) { if (tid < 15 * 31) rpb_l[tid] = R.rpbv * INV_SCALE; }
    float m_reg = NEG, l_reg = 0; f32x16 o[4] = {};
    const int sr = tid >> 4, sc = (tid & 15) * 8, vst0 = v_st(sr, sc), vst1 = v_st(32 + sr, sc);
    const int vb0 = (int)(uintptr_t)V_lds + v_rd_base(lane);
#define ATT_SLOAD(i, j) sload<i>(u, R, (j), sr, sc)
#define ATT_SWRITE(b, i) do { *(bf16x8*)(V_lds + (b) * SHM_V + vst0) = R.vs0[i]; *(bf16x8*)(V_lds + (b) * SHM_V + vst1) = R.vs1[i]; const int kc_ = sc * 2;  \
    *(bf16x8*)(K_lds + (b) * SHM_K + KSWZ(sr, kc_)) = R.ks0[i]; *(bf16x8*)(K_lds + (b) * SHM_K + KSWZ(32 + sr, kc_)) = R.ks1[i]; } while (0)
#define ATT_SWAIT() asm volatile("s_waitcnt vmcnt(4)" ::: "memory")
#define ATT_RESC(a) do { if (__any((a) < 1.f)) { _Pragma("unroll") for (int d = 0; d < 4; ++d) _Pragma("unroll") for (int r = 0; r < 16; ++r) o[d][r] *= (a); } } while (0)
    f32x16 pA0, pA1, pB0, pB1; float mnA, mnB, alA, alB; bf16x8 pa0, pa1, pa2, pa3; const int NT = u.nt;
    constexpr int SE = 0, SO = 1;
    ATT_SWRITE(0, SE);
    {
        const unsigned gl = (unsigned)(uintptr_t)(lds + OFF_STG) + (unsigned)wid * (unsigned)STG_WAVE;
#pragma unroll
        for (int t = 0; t < 8; ++t) { const int rr = 4 * t + (lane >> 4), c = (lane & 15) ^ (rr & 15); const unsigned voff = (unsigned)(((wid * QBLK + rr) * LDQ + c * 8) * 2);
            asm volatile("s_mov_b32 m0, %0\n\ts_nop 0\n\tglobal_load_lds_dwordx4 %1, %2" :: "s"(gl + t * 1024), "v"(voff), "s"(u.gate) : "memory"); }
    }
    ATT_SLOAD(SE, 2);
    if (has_prev) attn_flush(R);
    __syncthreads();
    qkt(pA0, pA1, K_lds, R.qr, r32, hi); apply_mask(pA0, pA1, u, 0, wid, r32, hi, rpb_l); partialSM(pA0, pA1, m_reg, mnA, alA);
    ATT_SWRITE(1, SO); __syncthreads();
    for (int j = 1; j + 1 < NT; j += 2) {
        SBAR(); qkt(pB0, pB1, K_lds + SHM_K, R.qr, r32, hi);
        finishSM(pA0, pA1, alA, l_reg, pa0, pa1, pa2, pa3); SBAR();
        ATT_SLOAD(SO, j + 2); SBAR();
        pv_d0(o, vb0, pa0, pa1, pa2, pa3); apply_mask(pB0, pB1, u, j, wid, r32, hi, rpb_l); partialSM(pB0, pB1, m_reg, mnB, alB);
        __syncthreads(); ATT_SWAIT(); ATT_SWRITE(0, SE);
        ATT_RESC(alB); __syncthreads();
        SBAR(); qkt(pA0, pA1, K_lds, R.qr, r32, hi);
        finishSM(pB0, pB1, alB, l_reg, pa0, pa1, pa2, pa3); SBAR();
        ATT_SLOAD(SE, j + 3 < NT ? j + 3 : NT - 1); SBAR();
        pv_d0(o, vb0 + (int)SHM_V, pa0, pa1, pa2, pa3); apply_mask(pA0, pA1, u, j + 1, wid, r32, hi, rpb_l); partialSM(pA0, pA1, m_reg, mnA, alA);
        __syncthreads(); ATT_SWAIT(); ATT_SWRITE(1, SO);
        ATT_RESC(alA); __syncthreads();
    }
    SBAR(); qkt(pB0, pB1, K_lds + SHM_K, R.qr, r32, hi);
    finishSM(pA0, pA1, alA, l_reg, pa0, pa1, pa2, pa3); SBAR();
    if (has_next) attn_prefetch(nu, R);
    SBAR();
    pv_d0(o, vb0, pa0, pa1, pa2, pa3); apply_mask(pB0, pB1, u, NT - 1, wid, r32, hi, rpb_l); partialSM(pB0, pB1, m_reg, mnB, alB);
    __syncthreads(); ATT_RESC(alB);
    finishSM(pB0, pB1, alB, l_reg, pa0, pa1, pa2, pa3); SBAR();
    typedef unsigned u32x2 __attribute__((ext_vector_type(2)));
    u32x2 g8[16];
    { const char* gs_ = lds + OFF_STG + wid * STG_WAVE + r32 * 256 + hi * 8; const int rx = r32 & 15;
#pragma unroll
      for (int c = 0; c < 16; ++c) g8[c] = *reinterpret_cast<const u32x2*>(gs_ + ((c ^ rx) << 4)); }
    SBAR();
    pv_d0(o, vb0 + (int)SHM_V, pa0, pa1, pa2, pa3);
    if (u.has_sink) l_reg += __builtin_amdgcn_exp2f(((const float*)(lds + OFF_SINK))[u.sink_i] * 1.4426950408889634f - m_reg * (SCALE * 1.4426950408889634f));
    const float rl = 8.0f * __builtin_amdgcn_rcpf(l_reg);
    int hi_e = hi, r32_e = r32, lane_e = lane; asm volatile("" : "+v"(hi_e), "+v"(r32_e), "+v"(lane_e));
    char* stg = lds + OFF_STG + wid * STG_WAVE;
    { typedef float f32x2 __attribute__((ext_vector_type(2)));
      char* yw = stg + r32_e * YST_ROW + hi_e * 4;
#pragma unroll
      for (int d0 = 0; d0 < 4; ++d0) {
        f32x2 g[8], o2[8], d[8];
#pragma unroll
        for (int p = 0; p < 8; ++p) { const unsigned gw = g8[d0 * 4 + (p >> 1)][p & 1]; g[p] = (f32x2){__uint_as_float(gw << 16), __uint_as_float(gw & 0xffff0000u)};
            o2[p] = (f32x2){o[d0][2 * p] * rl, o[d0][2 * p + 1] * rl}; d[p] = g[p] * -1.4426950408889634f; }
        SBAR();
#pragma unroll
        for (int p = 0; p < 8; ++p) d[p] = (f32x2){__builtin_amdgcn_exp2f(d[p].x), __builtin_amdgcn_exp2f(d[p].y)};
        SBAR();
#pragma unroll
        for (int p = 0; p < 8; ++p) d[p] = d[p] + 1.0f;
        SBAR();
#pragma unroll
        for (int p = 0; p < 8; ++p) d[p] = (f32x2){__builtin_amdgcn_rcpf(d[p].x), __builtin_amdgcn_rcpf(d[p].y)};
        SBAR();
#pragma unroll
        for (int p = 0; p < 8; ++p) o2[p] = o2[p] * (g[p] * d[p]);
        SBAR();
#pragma unroll
        for (int k = 0; k < 4; ++k) { int w0 = 0; w0 = __builtin_amdgcn_cvt_pk_fp8_f32(o2[2 * k].x, o2[2 * k].y, w0, false); w0 = __builtin_amdgcn_cvt_pk_fp8_f32(o2[2 * k + 1].x, o2[2 * k + 1].y, w0, true);
            *reinterpret_cast<unsigned*>(yw + (d0 * 4 + k) * 8) = (unsigned)w0; }
        SBAR();
      } }
    asm volatile("s_waitcnt lgkmcnt(0)" ::: "memory");
    unsigned char* ow = u.out + (size_t)(wid * QBLK) * LDO;
#pragma unroll
    for (int i = 0; i < 4; ++i) { const int id = i * 64 + lane_e, row = id >> 3, c16 = (id & 7) * 16; R.w[i] = *reinterpret_cast<const u32x4*>(stg + row * YST_ROW + c16); }
    asm volatile("s_waitcnt lgkmcnt(0)" ::: "memory");
    R.wp = ow + (size_t)(lane_e >> 3) * LDO + (lane_e & 7) * 16;
#undef ATT_SLOAD
#undef ATT_SWRITE
#undef ATT_SWAIT
#undef ATT_RESC
}
#undef KSWZ
#undef SBAR
}

constexpr int D = 4096, NCTX = 8192, NLAT = 8192, M_TOK = NCTX + NLAT;
constexpr int CTX_B = 32, CTX_L = 256, LAT_B = 8, LAT_L = 1024, PAST = 512, GRID_W = 64;
constexpr int HD = 128, NIN = 13312, NPIN = 8192;
constexpr int LDA = D + 64, LDG = 1024 + 64, LD8 = D + 128;
constexpr int C_QA = 0, C_KA = 2048, C_VA = 2560, C_QB = 3072, C_KB = 5120, C_VB = 7168, C_GATE = 9216;
constexpr int NCOND = 9, NMOD = 3 * D;
constexpr int KSPLIT = 16;
constexpr float NORM_EPS = 1e-6f;
constexpr size_t OFF_Y = 0, OFF_NAK = (size_t)M_TOK * D, OFF_NAV = OFF_NAK + (size_t)NCTX * 512, OFF_NBK = OFF_NAV + (size_t)NCTX * 512, OFF_NBV = OFF_NBK + (size_t)NCTX * 2048, OUT_TOTAL = OFF_NBV + (size_t)NCTX * 2048;

constexpr size_t MiB = 1u << 20;
constexpr size_t WS_CTL = 0, CTL_ZERO_BYTES = 32768;
constexpr size_t WS_MODP = 1 * MiB;
constexpr size_t WS_MODF = 15 * MiB;
constexpr size_t WS_WIN = 16 * MiB;
constexpr size_t WS_WKV = 70 * MiB;
constexpr size_t WS_WOUT = 122 * MiB;
constexpr size_t WS_WPIN = 155 * MiB;
constexpr size_t WS_WGRP = 220 * MiB;
constexpr size_t WS_WPOUT = 229 * MiB;
constexpr size_t WS_CAK = 262 * MiB, WS_CAV = 266 * MiB, WS_CBK = 270 * MiB, WS_CBV = 286 * MiB;
constexpr size_t WS_H = 302 * MiB;
constexpr size_t WS_H16 = 370 * MiB;
constexpr size_t WS_QKVG = 436 * MiB;
constexpr size_t WS_ATT = 852 * MiB;
constexpr size_t WS_X1 = 982 * MiB;
constexpr size_t WS_X2 = 1110 * MiB;
constexpr size_t WS_WU = 1238 * MiB;
constexpr size_t WS_WQ = 1272 * MiB;
constexpr size_t WS_WQ2 = 1306 * MiB;
constexpr size_t WS_END = 1324 * MiB;
constexpr size_t WS_ROPE = 15 * MiB + 1015808;
constexpr size_t WS_SCL = 15 * MiB + 917504;
static_assert(WS_WIN + (size_t)NIN * LD8 <= WS_WKV && WS_WKV + (size_t)5120 * LDA * 2 <= WS_WOUT && WS_WOUT + (size_t)D * LD8 <= WS_WPIN && WS_WPIN + (size_t)NPIN * LDA * 2 <= WS_WGRP && WS_WGRP + (size_t)4096 * LDG * 2 <= WS_WPOUT && WS_WPOUT + (size_t)D * LDA * 2 <= WS_CAK, "weights map");
static_assert(WS_H + (size_t)M_TOK * LD8 <= WS_H16 && WS_H16 + (size_t)NCTX * LDA * 2 <= WS_QKVG && WS_H + (size_t)M_TOK * LDA * 2 <= WS_QKVG && WS_QKVG + (size_t)M_TOK * NIN * 2 <= WS_ATT && WS_ATT + (size_t)M_TOK * LDA * 2 <= WS_X1 && WS_X1 + (size_t)M_TOK * D * 2 <= WS_X2 && WS_X2 + (size_t)M_TOK * D * 2 <= WS_WU && WS_WU + (size_t)D * LDA * 2 <= WS_WQ && WS_WQ + (size_t)NPIN * LD8 <= WS_WQ2 && WS_WQ2 + (size_t)D * LD8 <= WS_END && WS_MODF + (size_t)2 * NCOND * NMOD * 4 <= WS_SCL && WS_SCL + (M_TOK + NPIN + D) * 4 <= 16 * MiB, "activation map");
constexpr int CW_TMO = 0, CW_CODE = 1, CW_BAR = 4096;

constexpr int NWAVES = 8, NTHREADS = NWAVES * 64;
constexpr int LDS_BYTES = 150528;
constexpr int RING_OFF = 0, RING_BYTES = LDS_BYTES - 512;
constexpr int ROPE_LDS_OFF = 131072;
constexpr int LDSCTL_OFF = RING_BYTES, MISC_OFF = LDSCTL_OFF + 320;
static_assert(8 * 16640 <= RING_BYTES && MISC_OFF + 128 <= LDS_BYTES && (int)att::SHM_ATTN <= RING_BYTES && ROPE_LDS_OFF + 2 * 64 * pg8::ROPE_LD * 4 <= RING_BYTES, "LDS map");

#define GAS __attribute__((address_space(1)))
#define LAS __attribute__((address_space(3)))
typedef unsigned short bf16;
typedef unsigned v4u __attribute__((ext_vector_type(4)));
typedef unsigned v2u __attribute__((ext_vector_type(2)));
typedef float f32x4 __attribute__((ext_vector_type(4)));
typedef GAS unsigned gu32;
#define RLX_AGENT __ATOMIC_RELAXED, __HIP_MEMORY_SCOPE_AGENT
#define LDS_WAIT() asm volatile("s_waitcnt lgkmcnt(0)" ::: "memory")
#define VM_WAIT() asm volatile("s_waitcnt vmcnt(0)" ::: "memory")
__device__ __forceinline__ unsigned f2bf(float f) { unsigned u = __builtin_bit_cast(unsigned, f); return (u + 0x7fffu + ((u >> 16) & 1u)) >> 16; }
__device__ __forceinline__ unsigned pk2(float lo, float hi) { unsigned r; asm("v_cvt_pk_bf16_f32 %0, %1, %2" : "=v"(r) : "v"(lo), "v"(hi)); return r; }
__device__ __forceinline__ float bflo(unsigned w) { return __uint_as_float(w << 16); }
__device__ __forceinline__ float bfhi(unsigned w) { return __uint_as_float(w & 0xffff0000u); }
__device__ __forceinline__ float silu(float x) { return x / (1.0f + __expf(-x)); }
constexpr size_t QBLK_STRIDE = (size_t)M_TOK * HD;
__device__ __forceinline__ size_t qoff(size_t row, int col) { return (size_t)(col >> 7) * QBLK_STRIDE + row * HD + (col & 127); }


constexpr float S8_W = 256.0f, S8_ATT = 8.0f, S8_H = 4.0f;
__device__ __forceinline__ unsigned pk4_i8(float a, float b, float c, float d) {
    unsigned r = 0;
    r = __builtin_amdgcn_cvt_pk_u8_f32(a + 128.0f, 0, r); r = __builtin_amdgcn_cvt_pk_u8_f32(b + 128.0f, 1, r); r = __builtin_amdgcn_cvt_pk_u8_f32(c + 128.0f, 2, r); r = __builtin_amdgcn_cvt_pk_u8_f32(d + 128.0f, 3, r);
    return r ^ 0x80808080u;
}
__device__ __forceinline__ unsigned pk4_fp8(float a, float b, float c, float d) {
    int r = 0; r = __builtin_amdgcn_cvt_pk_fp8_f32(a, b, r, false); r = __builtin_amdgcn_cvt_pk_fp8_f32(c, d, r, true); return (unsigned)r;
}

#define XB_TMO      128
#define XB_XCNT(j)  (256  + 64 * (j))
#define XB_XSUB(j)  (1280 + 64 * (j))
#define XB_XGEN(j)  (2304 + 64 * (j))
#define XB_TOP      3328
#define XB_TOPGEN   3392
#define XCD_BAR_WORDS 3456
#define XB_SPIN_CAP (1u << 18)

__device__ __forceinline__ unsigned xb_ld(unsigned* p)              { return __hip_atomic_load(p, __ATOMIC_RELAXED, __HIP_MEMORY_SCOPE_AGENT); }
__device__ __forceinline__ unsigned xb_add(unsigned* p, unsigned v) { return __hip_atomic_fetch_add(p, v, __ATOMIC_RELAXED, __HIP_MEMORY_SCOPE_AGENT); }
__device__ __forceinline__ unsigned xb_xcc_id() { return (unsigned)__builtin_amdgcn_s_getreg((3 << 11) | 20) & 0xFu; }
#define XB_SPIN(cond, bar) do { unsigned _sp = 0; while (cond) { __builtin_amdgcn_s_sleep(1); \
    if ((++_sp & 255u) == 0u) { if (xb_ld(&(bar)[XB_TMO])) break; if (_sp > XB_SPIN_CAP) { atomicAdd(&(bar)[XB_TMO], 1u); break; } } } } while (0)

struct XcdBarrier {
    unsigned* bar; unsigned x;
    volatile LAS unsigned* st;
};

__device__ __forceinline__ XcdBarrier xcd_barrier_post(unsigned* bar, volatile LAS unsigned* st) {
    XcdBarrier b; b.bar = bar; b.x = xb_xcc_id(); b.st = st;
    if (threadIdx.x == 0) (void)xb_add(&bar[XB_XCNT(b.x)], 1u);
    return b;
}
__device__ __forceinline__ void xcd_barrier_complete(unsigned* bar, unsigned x, unsigned& nloc, unsigned& nx) {
    const unsigned G = gridDim.x * gridDim.y * gridDim.z;
    unsigned sum, cnt, mine, sp = 0u;
    for (;;) {
        sum = 0u; cnt = 0u; mine = 0u;
#pragma unroll
        for (unsigned j = 0; j < 16; ++j) { const unsigned c = xb_ld(&bar[XB_XCNT(j)]); sum += c; cnt += (c > 0u) ? 1u : 0u; mine = (j == x) ? c : mine; }
        if (sum == G) break;
        __builtin_amdgcn_s_sleep(1);
        if ((++sp & 255u) == 0u) { if (xb_ld(&bar[XB_TMO])) break; if (sp > XB_SPIN_CAP) { atomicAdd(&bar[XB_TMO], 1u); break; } }
    }
    nloc = mine > 0u ? mine : 1u; nx = cnt > 0u ? cnt : 1u;
}

__device__ __forceinline__ void xcd_barrier(const XcdBarrier& b) {
    asm volatile("s_waitcnt vmcnt(0)" ::: "memory");
    __syncthreads();
    if (threadIdx.x == 0) {
        unsigned* bar = b.bar;
        __builtin_amdgcn_s_waitcnt(0);
        unsigned nloc = b.st[0], nx = b.st[1];
        if (nloc == 0u) { xcd_barrier_complete(bar, b.x, nloc, nx); b.st[0] = nloc; b.st[1] = nx; }
        const unsigned old = xb_add(&bar[XB_XSUB(b.x)], 1u);
        const unsigned gen = old / nloc;
        if (old + 1u == (gen + 1u) * nloc) {
            __builtin_amdgcn_fence(__ATOMIC_RELEASE, "agent");
            asm volatile("s_waitcnt vmcnt(0)" ::: "memory");
            const unsigned og = xb_add(&bar[XB_TOP], 1u);
            const unsigned tg = og / nx;
            if (og + 1u == (tg + 1u) * nx) xb_add(&bar[XB_TOPGEN], 1u);
            else XB_SPIN(xb_ld(&bar[XB_TOPGEN]) == tg, bar);
            __builtin_amdgcn_fence(__ATOMIC_ACQUIRE, "agent");
            xb_add(&bar[XB_XGEN(b.x)], 1u);
            asm volatile("s_waitcnt vmcnt(0)" ::: "memory");
        } else {
            XB_SPIN(xb_ld(&bar[XB_XGEN(b.x)]) == gen, bar);
            __builtin_amdgcn_fence(__ATOMIC_ACQUIRE, "agent");
            asm volatile("s_waitcnt vmcnt(0)" ::: "memory");
        }
    }
    __syncthreads();
}
static_assert((size_t)(CW_BAR + XCD_BAR_WORDS) * 4 <= CTL_ZERO_BYTES, "the per-call memset covers the barrier words");

__device__ __forceinline__ float wave_sum(float v) {
#pragma unroll
    for (int o = 1; o < 64; o <<= 1) v += __shfl_xor(v, o);
    return v;
}

struct Frame {
    LAS unsigned char* lds;
    volatile LAS unsigned* MISC;
    gu32* ctl;
    int tid, lane, wave, vcu, G;
    const float *x_prompt, *x_sample, *c_lat, *cache_ak, *cache_av, *cache_bk, *cache_bv, *c_ctx, *w_ada, *b_ada, *norm_g, *w_in_attn, *a_sink, *b_rpb, *w_out_attn, *w_in_pool, *w_grp, *pool_scale, *w_out_pool, *final_g;
    float* out;
    float *modp, *modf, *sA1, *sW, *sW2; bf16 *X1, *X2; unsigned char *Wq, *Wq2;
    float* rope_tab;
    bf16 *Wt_in, *Wt_kv, *Wt_out, *Wt_pin, *Wt_grp, *Wt_pout, *Wu, *H16, *cak, *cav, *cbk, *cbv, *H, *QKVG, *ATT;
};

struct TItem { const float* src; unsigned char* d8; bf16* d16; int N, perm; };
constexpr int TI_IN = (D / 64) * (NIN / 64), TI_OUT = (D / 64) * (D / 64), TI_PIN = (D / 64) * (D / 64), TI_GRP1 = (1024 / 64) * (1024 / 64), TI_POUT = TI_OUT;
constexpr int TI_TOTAL = TI_IN + TI_OUT + TI_PIN + 4 * TI_GRP1 + TI_POUT;
__device__ __forceinline__ int rope_row(int n) { const int L = n & 255, head = L >> 7, blk = (L >> 6) & 1, half = (L >> 5) & 1, i = L & 31; return (n & ~255) + half * 128 + head * 64 + blk * 32 + i; }
__device__ __forceinline__ int kv_compact(int n) { return n < C_QB ? n - C_KA : n - C_KB + 1024; }
__device__ __forceinline__ TItem titem(Frame& F, int it, int& ld16) {
    const float* W; int N, ncols; int r = it; int kind;
    bf16* WT = nullptr;
    ld16 = LDA;
    if (r < TI_IN) { W = F.w_in_attn; N = NIN; ncols = NIN; kind = 0; }
    else if ((r -= TI_IN) < TI_OUT) { W = F.w_out_attn; N = D; ncols = D; kind = 1; }
    else if ((r -= TI_OUT) < TI_PIN) { W = F.w_in_pool + D; WT = F.Wt_pin + (size_t)D * LDA; N = NPIN; ncols = D; kind = 2; }
    else if ((r -= TI_PIN) < 4 * TI_GRP1) { const int g = r / TI_GRP1; r -= g * TI_GRP1; W = F.w_grp + (size_t)g * 1024 * 1024; WT = F.Wt_grp + (size_t)g * 1024 * LDG; N = 1024; ncols = 1024; ld16 = LDG; kind = 2; }
    else { r -= 4 * TI_GRP1; W = F.w_out_pool; WT = F.Wt_pout; N = D; ncols = D; kind = 2; }
    const int nblk = ncols / 64, kb = r / nblk, nb = r % nblk, n0 = 64 * nb, k0 = 64 * kb;
    TItem t; t.src = W + (size_t)k0 * N + n0; t.N = N; t.d8 = nullptr; t.d16 = nullptr; t.perm = -1;
    if (kind == 0) { t.d8 = (unsigned char*)F.Wt_in + (size_t)n0 * LD8 + k0; if (n0 < C_VA) { t.d8 = (unsigned char*)F.Wt_in + k0; t.perm = n0; }
        const bool kv = (n0 >= C_KA && n0 < C_QB) || (n0 >= C_KB && n0 < C_GATE); if (kv) t.d16 = F.Wt_kv + (size_t)kv_compact(n0) * LDA + k0; }
    else if (kind == 1) t.d8 = (unsigned char*)F.Wt_out + (size_t)n0 * LD8 + k0;
    else t.d16 = WT + (size_t)n0 * ld16 + k0;
    return t;
}
__device__ __forceinline__ void titem_load(f32x4 (&v)[16], const TItem& t, int lane) {
    const int q = lane >> 4, n4 = (lane & 15) * 4;
#pragma unroll
    for (int i = 0; i < 16; ++i) v[i] = __builtin_nontemporal_load((const GAS f32x4*)(t.src + (size_t)(4 * i + q) * t.N + n4));
}
__device__ __forceinline__ void titem_store(const f32x4 (&v)[16], const TItem& t, int ld16, LAS float* scr, int lane) {
    const int q = lane >> 4, n4 = (lane & 15) * 4;
#pragma unroll
    for (int i = 0; i < 16; ++i) { LAS float* d = scr + (4 * i + q) * 65 + n4; d[0] = v[i].x; d[1] = v[i].y; d[2] = v[i].z; d[3] = v[i].w; }
    LDS_WAIT(); asm volatile("" ::: "memory");
    const int c = lane & 7;
#pragma unroll
    for (int j = 0; j < 8; ++j) { const int n = (lane >> 3) + 8 * j; const LAS float* s = scr + (8 * c) * 65 + n;
        if (t.d8) { v2u o; o.x = pk4_fp8(s[0 * 65] * S8_W, s[1 * 65] * S8_W, s[2 * 65] * S8_W, s[3 * 65] * S8_W); o.y = pk4_fp8(s[4 * 65] * S8_W, s[5 * 65] * S8_W, s[6 * 65] * S8_W, s[7 * 65] * S8_W);
            *(GAS v2u*)(t.d8 + (size_t)(t.perm >= 0 ? rope_row(t.perm + n) : n) * LD8 + 8 * c) = o; }
        if (t.d16) { v4u o; o.x = pk2(s[0 * 65], s[1 * 65]); o.y = pk2(s[2 * 65], s[3 * 65]); o.z = pk2(s[4 * 65], s[5 * 65]); o.w = pk2(s[6 * 65], s[7 * 65]);
            *(GAS v4u*)(t.d16 + (size_t)n * ld16 + 8 * c) = o; } }
    LDS_WAIT(); asm volatile("" ::: "memory");
}
constexpr int ADA_NC = NMOD / 256, ADA_ITEMS = 2 * KSPLIT * ADA_NC, ADA_KS = D / KSPLIT;
__device__ __forceinline__ void p0_ada_item(Frame& F, int a) {
    const int l = a / (KSPLIT * ADA_NC), rem = a % (KSPLIT * ADA_NC), s = rem / ADA_NC, nc = rem % ADA_NC;
    const int k0 = s * ADA_KS, n0 = nc * 256 + F.lane * 4;
    f32x4 acc[NCOND];
#pragma unroll
    for (int j = 0; j < NCOND; ++j) acc[j] = (f32x4){0.f, 0.f, 0.f, 0.f};
    const float* wp = F.w_ada + ((size_t)l * D + k0) * NMOD + n0;
    for (int kb = 0; kb < ADA_KS / 64; ++kb) {
        float cv[NCOND];
        cv[0] = silu(F.c_ctx[k0 + kb * 64 + F.lane]);
#pragma unroll
        for (int j = 1; j < NCOND; ++j) cv[j] = silu(F.c_lat[(size_t)(j - 1) * D + k0 + kb * 64 + F.lane]);
#pragma unroll 16
        for (int kk = 0; kk < 64; ++kk) {
            const f32x4 w = __builtin_nontemporal_load((const f32x4*)(wp + (size_t)(kb * 64 + kk) * NMOD));
#pragma unroll
            for (int j = 0; j < NCOND; ++j) { const float cj = __builtin_bit_cast(float, __builtin_amdgcn_readlane(__builtin_bit_cast(int, cv[j]), kk)); acc[j] += w * cj; }
        }
    }
#pragma unroll
    for (int j = 0; j < NCOND; ++j) *(f32x4*)(F.modp + (((size_t)s * 2 + l) * NCOND + j) * NMOD + n0) = acc[j];
}
__device__ __forceinline__ void p0_prologue(Frame& F) {
    LAS float* scr = (LAS float*)(F.lds + RING_OFF + F.wave * 16640);
    const int gw = F.vcu * NWAVES + F.wave, NGW = F.G * NWAVES;
    for (int a = gw; a < ADA_ITEMS; a += NGW) p0_ada_item(F, a);
    int n, base, stride, off;
    if (NGW == 2048) { const bool ada = gw < ADA_ITEMS; n = ada ? 11 : 19; base = ada ? 0 : ADA_ITEMS * 11; stride = ada ? ADA_ITEMS : 2048 - ADA_ITEMS; off = ada ? gw : gw - ADA_ITEMS; }
    else { n = (TI_TOTAL - gw + NGW - 1) / NGW; base = 0; stride = NGW; off = gw; }
    if (n > 0) {
        f32x4 va[16], vb[16]; int la = LDA, lb = LDA;
        TItem ta = titem(F, base + off, la), tb = ta;
        titem_load(va, ta, F.lane);
        for (int i = 0; i < n; i += 2) {
            if (i + 1 < n) { tb = titem(F, base + (i + 1) * stride + off, lb); titem_load(vb, tb, F.lane); }
            titem_store(va, ta, la, scr, F.lane);
            if (i + 1 < n) {
                if (i + 2 < n) { ta = titem(F, base + (i + 2) * stride + off, la); titem_load(va, ta, F.lane); }
                titem_store(vb, tb, lb, scr, F.lane);
            }
        }
    }
    if (blockIdx.x == 0) for (int e = F.tid; e < 64 * 32; e += NTHREADS) {
        const int pos = e >> 5, i = e & 31; const float invf = exp2f(-(float)i * (13.287712379549449f / 32.0f));
        float sn, cs; sincosf((float)pos * invf, &sn, &cs); F.rope_tab[e] = cs; F.rope_tab[2048 + e] = sn; }
    for (int k = gw; k < D; k += NGW) {
        const float* src = F.w_in_pool + (size_t)k * NPIN; bf16* dst = F.Wu + (size_t)k * LDA;
#pragma unroll
        for (int q = 0; q < 8; ++q) { const int c = q * 512 + F.lane * 8; const f32x4 a = *(const GAS f32x4*)(src + c), b = *(const GAS f32x4*)(src + c + 4);
            v4u w; w.x = pk2(a.x, a.y); w.y = pk2(a.z, a.w); w.z = pk2(b.x, b.y); w.w = pk2(b.z, b.w); *(GAS v4u*)(dst + c) = w; }
    }
}

template <bool PART, class TX> __device__ __forceinline__ void norm_phase(Frame& F, const TX* xP, const TX* xS, const float* gvec, int layer) {
    LAS float* tA = (LAS float*)(F.lds + RING_OFF); LAS float* tB = tA + D;
    for (int rg = blockIdx.x; rg < M_TOK / 64; rg += F.G) {
        const int j = rg < NCTX / 64 ? 0 : 1 + (rg - NCTX / 64) / (LAT_L / 64);
        __syncthreads();
        for (int c = F.tid; c < D; c += NTHREADS) {
            float sh, sc;
            if (PART) { sh = F.b_ada[(size_t)layer * NMOD + c]; sc = F.b_ada[(size_t)layer * NMOD + D + c];
                for (int s = 0; s < KSPLIT; ++s) { const float* p = F.modp + (((size_t)s * 2 + layer) * NCOND + j) * NMOD; sh += p[c]; sc += p[D + c]; } }
            else { const float* p = F.modf + ((size_t)layer * NCOND + j) * NMOD; sh = p[c]; sc = p[D + c]; }
            tA[c] = gvec[c] * (1.0f + sc); tB[c] = sh;
        }
        __syncthreads();
        for (int i = 0; i < 8; ++i) {
            const int row = rg * 64 + F.wave * 8 + i;
            const TX* xr = row < NCTX ? xP + (size_t)row * D : xS + (size_t)(row - NCTX) * D;
            f32x4 v[16]; float ss = 0.f;
#pragma unroll
            for (int q = 0; q < 16; ++q) { if constexpr (sizeof(TX) == 4) v[q] = *(const f32x4*)(xr + q * 256 + F.lane * 4); else { const v2u w = *(const v2u*)(xr + q * 256 + F.lane * 4); v[q] = (f32x4){bflo(w.x), bfhi(w.x), bflo(w.y), bfhi(w.y)}; }
                ss += (v[q].x * v[q].x + v[q].y * v[q].y) + (v[q].z * v[q].z + v[q].w * v[q].w); }
            const float rstd = rsqrtf(wave_sum(ss) * (1.0f / D) + NORM_EPS);
            bf16* orow = F.H16 + (size_t)row * LDA; unsigned char* orow8 = (unsigned char*)F.H + (size_t)row * LD8;
            if (PART) {
                const bool w16 = row < NCTX;
#pragma unroll
                for (int q = 0; q < 16; ++q) { const int c = q * 256 + F.lane * 4; const f32x4 a = *(const LAS f32x4*)(tA + c), b = *(const LAS f32x4*)(tB + c);
                    const f32x4 o = v[q] * rstd * a + b;
                    if (w16) { v2u w; w.x = pk2(o.x, o.y); w.y = pk2(o.z, o.w); *(v2u*)(orow + c) = w; }
                    *(unsigned*)(orow8 + c) = pk4_fp8(o.x * S8_H, o.y * S8_H, o.z * S8_H, o.w * S8_H); }
            } else {
                float mx = 1e-20f;
#pragma unroll
                for (int q = 0; q < 16; ++q) { const int c = q * 256 + F.lane * 4; const f32x4 a = *(const LAS f32x4*)(tA + c), b = *(const LAS f32x4*)(tB + c);
                    v[q] = v[q] * rstd * a + b; mx = fmaxf(mx, fmaxf(fmaxf(fabsf(v[q].x), fabsf(v[q].y)), fmaxf(fabsf(v[q].z), fabsf(v[q].w)))); }
#pragma unroll
                for (int off = 1; off < 64; off <<= 1) mx = fmaxf(mx, __shfl_xor(mx, off));
                const float qi = 127.0f / mx;
                if (F.lane == 0) F.sA1[row] = mx * (1.0f / 127.0f);
#pragma unroll
                for (int q = 0; q < 16; ++q) { const int c = q * 256 + F.lane * 4; *(unsigned*)(orow8 + c) = pk4_i8(v[q].x * qi, v[q].y * qi, v[q].z * qi, v[q].w * qi); }
            }
        }
    }
    __syncthreads();
}

__device__ __forceinline__ void norm1_phase(Frame& F) {
    LAS float* tA = (LAS float*)(F.lds + RING_OFF); LAS float* tB = tA + D;
    const float* gvec = F.norm_g + D;
    for (int rg = blockIdx.x; rg < M_TOK / 64; rg += F.G) {
        const int j = rg < NCTX / 64 ? 0 : 1 + (rg - NCTX / 64) / (LAT_L / 64);
        __syncthreads();
        for (int c = F.tid; c < D; c += NTHREADS) { const float* p = F.modf + ((size_t)NCOND + j) * NMOD; tA[c] = gvec[c] * (1.0f + p[D + c]); tB[c] = p[c]; }
        __syncthreads();
#pragma unroll 1
        for (int hf = 0; hf < 4; ++hf) {
            const int row0 = rg * 64 + F.wave * 8 + hf * 2;
            v4u raw[2][8];
#pragma unroll
            for (int r = 0; r < 2; ++r) { const bf16* xr = F.X1 + (size_t)(row0 + r) * D + F.lane * 8;
#pragma unroll
                for (int k = 0; k < 8; ++k) raw[r][k] = *(const v4u*)(xr + k * 512); }
            asm volatile("" ::: "memory");
#pragma unroll
            for (int r = 0; r < 2; ++r) {
                float ss = 0.f;
#pragma unroll
                for (int k = 0; k < 8; ++k)
#pragma unroll
                    for (int e = 0; e < 4; ++e) { const float a = bflo(raw[r][k][e]), b = bfhi(raw[r][k][e]); ss += a * a + b * b; }
                const float rstd = rsqrtf(wave_sum(ss) * (1.0f / D) + NORM_EPS);
                float mx = 1e-20f;
#pragma unroll
                for (int k = 0; k < 8; ++k) { const int c = k * 512 + F.lane * 8;
                    const f32x4 a0 = *(const LAS f32x4*)(tA + c), a1 = *(const LAS f32x4*)(tA + c + 4), b0 = *(const LAS f32x4*)(tB + c), b1 = *(const LAS f32x4*)(tB + c + 4);
                    const v4u w = raw[r][k];
                    const f32x4 o0 = (f32x4){bflo(w[0]), bfhi(w[0]), bflo(w[1]), bfhi(w[1])} * rstd * a0 + b0, o1 = (f32x4){bflo(w[2]), bfhi(w[2]), bflo(w[3]), bfhi(w[3])} * rstd * a1 + b1;
                    mx = fmaxf(mx, fmaxf(fmaxf(fmaxf(fabsf(o0.x), fabsf(o0.y)), fmaxf(fabsf(o0.z), fabsf(o0.w))), fmaxf(fmaxf(fabsf(o1.x), fabsf(o1.y)), fmaxf(fabsf(o1.z), fabsf(o1.w)))));
                    raw[r][k] = (v4u){pk2(o0.x, o0.y), pk2(o0.z, o0.w), pk2(o1.x, o1.y), pk2(o1.z, o1.w)}; }
#pragma unroll
                for (int off = 1; off < 64; off <<= 1) mx = fmaxf(mx, __shfl_xor(mx, off));
                const float qi = 127.0f / mx;
                if (F.lane == 0) F.sA1[row0 + r] = mx * (1.0f / 127.0f);
                unsigned char* orow8 = (unsigned char*)F.H + (size_t)(row0 + r) * LD8 + F.lane * 8;
#pragma unroll
                for (int k = 0; k < 8; ++k) { const v4u w = raw[r][k]; v2u q;
                    q.x = pk4_i8(bflo(w[0]) * qi, bfhi(w[0]) * qi, bflo(w[1]) * qi, bfhi(w[1]) * qi); q.y = pk4_i8(bflo(w[2]) * qi, bfhi(w[2]) * qi, bflo(w[3]) * qi, bfhi(w[3]) * qi);
                    *(v2u*)(orow8 + k * 512) = q; }
                asm volatile("" ::: "memory");
            }
        }
    }
    __syncthreads();
}

__device__ __forceinline__ void norm0_phase(Frame& F) {
    LAS float* tA = (LAS float*)(F.lds + RING_OFF); LAS float* tB = tA + D;
    for (int rg = blockIdx.x; rg < M_TOK / 64; rg += F.G) {
        const int j = rg < NCTX / 64 ? 0 : 1 + (rg - NCTX / 64) / (LAT_L / 64);
        __syncthreads();
        for (int c = F.tid; c < D; c += NTHREADS) {
            float sh = F.b_ada[c], sc = F.b_ada[D + c];
            for (int s = 0; s < KSPLIT; ++s) { const float* p = F.modp + (((size_t)s * 2) * NCOND + j) * NMOD; sh += p[c]; sc += p[D + c]; }
            tA[c] = F.norm_g[c] * (1.0f + sc); tB[c] = sh;
        }
        __syncthreads();
#pragma unroll 1
        for (int hf = 0; hf < 4; ++hf) {
            const int row0 = rg * 64 + F.wave * 8 + hf * 2;
            f32x4 raw[2][16];
#pragma unroll
            for (int r = 0; r < 2; ++r) { const int row = row0 + r; const float* xr = (row < NCTX ? F.x_prompt + (size_t)row * D : F.x_sample + (size_t)(row - NCTX) * D) + F.lane * 4;
#pragma unroll
                for (int q = 0; q < 16; ++q) raw[r][q] = *(const f32x4*)(xr + q * 256); }
            asm volatile("" ::: "memory");
#pragma unroll
            for (int r = 0; r < 2; ++r) { const int row = row0 + r;
                float ss = 0.f;
#pragma unroll
                for (int q = 0; q < 16; ++q) { const f32x4 v = raw[r][q]; ss += (v.x * v.x + v.y * v.y) + (v.z * v.z + v.w * v.w); }
                const float rstd = rsqrtf(wave_sum(ss) * (1.0f / D) + NORM_EPS);
                bf16* orow = F.H16 + (size_t)row * LDA; unsigned char* orow8 = (unsigned char*)F.H + (size_t)row * LD8; const bool w16 = row < NCTX;
#pragma unroll
                for (int q = 0; q < 16; ++q) { const int c = q * 256 + F.lane * 4; const f32x4 a = *(const LAS f32x4*)(tA + c), b = *(const LAS f32x4*)(tB + c);
                    const f32x4 o = raw[r][q] * rstd * a + b;
                    if (w16) { v2u w; w.x = pk2(o.x, o.y); w.y = pk2(o.z, o.w); *(v2u*)(orow + c) = w; }
                    *(unsigned*)(orow8 + c) = pk4_fp8(o.x * S8_H, o.y * S8_H, o.z * S8_H, o.w * S8_H); }
                asm volatile("" ::: "memory");
            }
        }
    }
    __syncthreads();
}
__device__ __forceinline__ void p1_extras(Frame& F) {
    const int gt = blockIdx.x * NTHREADS + F.tid, NT = F.G * NTHREADS;
    for (int idx = gt; idx < 2 * NCOND * NMOD; idx += NT) {
        const int l = idx / (NCOND * NMOD), n = idx % NMOD; float v = F.b_ada[(size_t)l * NMOD + n];
        for (int s = 0; s < KSPLIT; ++s) v += F.modp[(size_t)s * 2 * NCOND * NMOD + idx];
        F.modf[idx] = v;
    }
}
__device__ __forceinline__ void cache_convert(Frame& F, int wt, int WT) {
    constexpr size_t NA8 = (size_t)LAT_B * PAST * 512 / 8, NB8 = (size_t)LAT_B * PAST * 2048 / 8, NTOT = 2 * NA8 + 2 * NB8;
    for (size_t i0 = wt; i0 < NTOT; i0 += (size_t)4 * WT) {
        f32x4 a[4], b[4]; bf16* dp[4];
#pragma unroll
        for (int u = 0; u < 4; ++u) { const size_t i = i0 + (size_t)u * WT; dp[u] = nullptr;
            if (i < NTOT) { const float* src; bf16* dst; size_t k = i;
                if (k < NA8) { src = F.cache_ak; dst = F.cak; } else if ((k -= NA8) < NA8) { src = F.cache_av; dst = F.cav; } else if ((k -= NA8) < NB8) { src = F.cache_bk; dst = F.cbk; } else { k -= NB8; src = F.cache_bv; dst = F.cbv; }
                a[u] = *(const f32x4*)(src + k * 8); b[u] = *(const f32x4*)(src + k * 8 + 4);
                const int lc = dst == F.cak || dst == F.cav ? 9 : 11;
                const size_t e = k * 8, row = e >> lc, col = e & (((size_t)1 << lc) - 1);
                dp[u] = dst + (col >> 7) * ((size_t)LAT_B * PAST * HD) + row * HD + (col & 127); } }
#pragma unroll
        for (int u = 0; u < 4; ++u) if (dp[u]) { v4u w; w.x = pk2(a[u].x, a[u].y); w.y = pk2(a[u].z, a[u].w); w.z = pk2(b[u].x, b[u].y); w.w = pk2(b[u].z, b[u].w); *(v4u*)dp[u] = w; }
    }
}


__device__ __forceinline__ void quant_weight_rows(Frame& F, const bf16* src, unsigned char* dst, float* sc, int nrows, int gw, int NGW) {
    for (int r0 = gw; r0 < nrows; r0 += 2 * NGW) {
        v4u x[2][8]; const int r1 = r0 + NGW < nrows ? r0 + NGW : r0;
#pragma unroll
        for (int q = 0; q < 8; ++q) { x[0][q] = *(const v4u*)(src + (size_t)r0 * LDA + q * 512 + F.lane * 8); x[1][q] = *(const v4u*)(src + (size_t)r1 * LDA + q * 512 + F.lane * 8); }
#pragma unroll
        for (int u = 0; u < 2; ++u) { const int r = u ? r1 : r0; if (u && r1 == r0) break;
            float mx = 1e-20f;
#pragma unroll
            for (int q = 0; q < 8; ++q)
#pragma unroll
                for (int e = 0; e < 4; ++e) mx = fmaxf(mx, fmaxf(fabsf(bflo(x[u][q][e])), fabsf(bfhi(x[u][q][e]))));
#pragma unroll
            for (int off = 1; off < 64; off <<= 1) mx = fmaxf(mx, __shfl_xor(mx, off));
            const float qi = 127.0f / mx; if (F.lane == 0) sc[r] = mx * (1.0f / 127.0f);
            unsigned char* o = dst + (size_t)r * LD8;
#pragma unroll
            for (int q = 0; q < 8; ++q) { v2u w; w.x = pk4_i8(bflo(x[u][q][0]) * qi, bfhi(x[u][q][0]) * qi, bflo(x[u][q][1]) * qi, bfhi(x[u][q][1]) * qi); w.y = pk4_i8(bflo(x[u][q][2]) * qi, bfhi(x[u][q][2]) * qi, bflo(x[u][q][3]) * qi, bfhi(x[u][q][3]) * qi);
                *(v2u*)(o + q * 512 + F.lane * 8) = w; } }
    }
}

__device__ __forceinline__ void side_jobs(Frame& F, int gw, int NGW) {
    quant_weight_rows(F, F.Wt_pin, F.Wq, F.sW, NPIN, gw, NGW); quant_weight_rows(F, F.Wt_pout, F.Wq2, F.sW2, D, gw, NGW);
    cache_convert(F, gw * 64 + F.lane, NGW * 64);
}
__device__ __forceinline__ att::Unit attn_make_unit(Frame& F, int w, int e) {
    const int kind = w >> 8, p = w & 255, idx = 2 * p + e;
    att::Unit u;
    u.kc = nullptr; u.vc = nullptr; u.nctx = 0; u.mask = 0; u.qpos0 = 0; u.kpos0 = 0; u.has_sink = 0; u.sink_i = 0; u.rpb = F.b_rpb;
    if (kind < 2) {
        const int b = idx >> 4, h = idx & 15; const size_t row0 = (size_t)b * CTX_L;
        const int qc = kind ? C_QB + h * HD : C_QA + h * HD, kcol = kind ? C_KB + h * HD : C_KA + (h >> 2) * HD, vcol = kind ? C_VB + h * HD : C_VA + (h >> 2) * HD, oc = kind * 2048 + h * HD;
        u.q = F.QKVG + qoff(row0, qc); u.kl = F.QKVG + qoff(row0, kcol); u.vl = F.QKVG + qoff(row0, vcol); u.nt = 4;
        if (kind == 0) { u.has_sink = 1; u.sink_i = h; }
        u.gate = F.QKVG + qoff(row0, C_GATE + oc); u.out = (unsigned char*)F.ATT + row0 * LD8 + oc;
    } else {
        const int qb = idx & 3, h = (idx >> 2) & 15, b = idx >> 6; const size_t seq0 = (size_t)NCTX + (size_t)b * LAT_L, row0 = seq0 + qb * 256;
        u.nctx = 8;
        if (kind == 2) {
            const int kstart = qb == 0 ? 0 : qb * 256 - 128, nloc = (qb == 0 || qb == 3) ? 6 : 8, kvh = h >> 2;
            u.q = F.QKVG + qoff(row0, C_QA + h * HD);
            u.kc = F.cak + ((size_t)kvh * LAT_B + b) * PAST * HD; u.vc = F.cav + ((size_t)kvh * LAT_B + b) * PAST * HD;
            u.kl = F.QKVG + qoff(seq0 + kstart, C_KA + kvh * HD); u.vl = F.QKVG + qoff(seq0 + kstart, C_VA + kvh * HD);
            u.nt = 8 + nloc; u.mask = 1; u.qpos0 = qb * 256; u.kpos0 = kstart; u.has_sink = 1; u.sink_i = h;
            u.gate = F.QKVG + qoff(row0, C_GATE + h * HD); u.out = (unsigned char*)F.ATT + row0 * LD8 + h * HD;
        } else {
            const int krow0 = qb < 2 ? 0 : (qb == 2 ? 4 : 8), nloc = (qb == 0 || qb == 3) ? 8 : 12;
            u.q = F.QKVG + qoff(row0, C_QB + h * HD);
            u.kc = F.cbk + ((size_t)h * LAT_B + b) * PAST * HD; u.vc = F.cbv + ((size_t)h * LAT_B + b) * PAST * HD;
            u.kl = F.QKVG + qoff(seq0 + krow0 * GRID_W, C_KB + h * HD); u.vl = F.QKVG + qoff(seq0 + krow0 * GRID_W, C_VB + h * HD);
            u.nt = 8 + nloc; u.mask = 2; u.qpos0 = qb * 4; u.kpos0 = krow0; u.rpb = F.b_rpb + (size_t)h * 15 * 31;
            u.gate = F.QKVG + qoff(row0, C_GATE + 2048 + h * HD); u.out = (unsigned char*)F.ATT + row0 * LD8 + 2048 + h * HD;
        }
    }
    return u;
}
__device__ __forceinline__ void attn_phase(Frame& F, char* lds, int wlimit = 1024) {
    const int nw = F.vcu < wlimit ? (wlimit - 1 - F.vcu) / F.G + 1 : 0, n = 2 * nw;
    if (n == 0) return;
    att::Regs R;
    if (F.tid < 16) ((float*)(lds + att::OFF_SINK))[F.tid] = F.a_sink[F.tid];
    const int rot = n == 8 ? 2 * ((F.vcu >> 3) & 3) : 0;
#define ATT_UNIT_OF(k_) attn_make_unit(F, F.vcu + ((n == 8 ? ((k_) + rot) & 7 : (k_)) >> 1) * F.G, (k_) & 1)
    att::Unit cur = ATT_UNIT_OF(0), nxt = cur;
    att::attn_prefetch(cur, R);
    for (int k = 0; k < n; ++k) {
        const bool has_next = k + 1 < n;
        if (has_next) nxt = ATT_UNIT_OF(k + 1);
        att::attn_unit(cur, has_next, nxt, R, lds, k > 0);
        cur = nxt;
    }
    att::attn_flush(R);
#undef ATT_UNIT_OF
}

__device__ __forceinline__ void pool_phase(Frame& F) {
    typedef float f32x2 __attribute__((ext_vector_type(2)));
    LAS v4u* ring = (LAS v4u*)(F.lds + RING_OFF) + F.tid;
    LAS float* pss = (LAS float*)(F.lds + RING_OFF + 16 * NTHREADS * 16);
    LAS float* qinv = pss + 8 * NTHREADS;
    static_assert(16 * NTHREADS * 16 + 8 * NTHREADS * 4 + 64 <= RING_BYTES, "pool LDS");
    const bf16* U = F.QKVG; unsigned char* Yq = (unsigned char*)F.ATT;
    const int col = F.tid * 8, half = 1 << (col >> 10);
    f32x2 psc2[4];
#pragma unroll
    for (int e = 0; e < 4; ++e) psc2[e] = (f32x2){F.pool_scale[col + 2 * e], F.pool_scale[col + 2 * e + 1]};
    for (int chunk = blockIdx.x; chunk < M_TOK / 64; chunk += F.G) {
        const int m0 = chunk * 64; int seq0, n;
        if (m0 < NCTX) { seq0 = m0 & ~(CTX_L - 1); n = CTX_L; } else { seq0 = NCTX + ((m0 - NCTX) & ~(LAT_L - 1)); n = LAT_L; }
        const int tl0 = m0 - seq0; const bf16* up = U + (size_t)seq0 * NPIN + col;
        f32x2 S2[4];
#pragma unroll
        for (int e = 0; e < 4; ++e) S2[e] = (f32x2){0.f, 0.f};
        { const int lo = tl0 - half < 0 ? 0 : tl0 - half, hi = tl0 + half > n ? n : tl0 + half;
          for (int tt = lo; tt < hi; ++tt) { const v4u ww = *(const v4u*)(up + (size_t)tt * NPIN); ring[(tt & 15) * NTHREADS] = ww;
#pragma unroll
              for (int e = 0; e < 4; ++e) S2[e] = S2[e] + (f32x2){bflo(ww[e]), bfhi(ww[e])}; } }
        v4u gat[2][4], add[2][4];
#define POOL_LOAD(b, g) do { _Pragma("unroll") for (int j = 0; j < 4; ++j) { const int t = tl0 + (g) * 4 + j; const int ta = t + half < n ? t + half : t; \
            gat[b][j] = *(const v4u*)(up + (size_t)t * NPIN + D); add[b][j] = *(const v4u*)(up + (size_t)ta * NPIN); } } while (0)
        POOL_LOAD(0, 0);
#pragma unroll 1
        for (int sub = 0; sub < 8; ++sub) {
            v4u yb[8];
#pragma unroll
            for (int gi = 0; gi < 2; ++gi) {
                const int g = sub * 2 + gi, gn = g + 1 < 16 ? g + 1 : 15;
                POOL_LOAD(gi ^ 1, gn);
                asm volatile("" ::: "memory");
#pragma unroll
                for (int j = 0; j < 4; ++j) { const int t = tl0 + g * 4 + j;
                    const int lo = t - half < 0 ? 0 : t - half, hi = t + half > n ? n : t + half; const float inv = __builtin_amdgcn_rcpf((float)(hi - lo));
                    const bool ha = t + half < n, hr = t - half >= 0;
                    const v4u cur = ring[(t & 15) * NTHREADS], rem = ring[((t - half) & 15) * NTHREADS];
                    if (ha) ring[((t + half) & 15) * NTHREADS] = add[gi][j];
                    float ss = 0.f;
#pragma unroll
                    for (int e = 0; e < 4; ++e) {
                        const f32x2 u2 = {bflo(cur[e]), bfhi(cur[e])}, g2 = {bflo(gat[gi][j][e]), bfhi(gat[gi][j][e])};
                        const f32x2 m2 = (S2[e] * inv - u2) * psc2[e];
                        const f32x2 t2 = g2 * -1.4426950408889634f; f32x2 d2 = {__builtin_amdgcn_exp2f(t2.x), __builtin_amdgcn_exp2f(t2.y)}; d2 = d2 + 1.0f;
                        const f32x2 r2 = {__builtin_amdgcn_rcpf(d2.x), __builtin_amdgcn_rcpf(d2.y)}, y2 = m2 * (g2 * r2);
                        ss = fmaxf(ss, fmaxf(fabsf(y2.x), fabsf(y2.y)));
                        yb[gi * 4 + j][e] = pk2(y2.x, y2.y);
                        const unsigned aw = ha ? add[gi][j][e] : 0u, rw = hr ? rem[e] : 0u;
                        S2[e] = S2[e] + ((f32x2){bflo(aw), bfhi(aw)} - (f32x2){bflo(rw), bfhi(rw)}); }
                    pss[(gi * 4 + j) * NTHREADS + F.tid] = ss; }
                asm volatile("" ::: "memory");
            }
            __syncthreads();
            { const int tok = F.wave; float a = 0.f;
#pragma unroll
              for (int i = 0; i < 8; ++i) a = fmaxf(a, pss[tok * NTHREADS + i * 64 + F.lane]);
#pragma unroll
              for (int off = 1; off < 64; off <<= 1) a = fmaxf(a, __shfl_xor(a, off));
              if (F.lane == 0) { const float step = fmaxf(a, 1e-20f) * (1.0f / 127.0f); qinv[tok] = 1.0f / step; F.sA1[seq0 + tl0 + sub * 8 + tok] = step; } }
            __syncthreads();
#pragma unroll
            for (int j = 0; j < 8; ++j) { const float qi = qinv[j]; float q[8];
#pragma unroll
                for (int e = 0; e < 4; ++e) { q[2 * e] = bflo(yb[j][e]) * qi; q[2 * e + 1] = bfhi(yb[j][e]) * qi; }
                v2u w; w.x = pk4_i8(q[0], q[1], q[2], q[3]); w.y = pk4_i8(q[4], q[5], q[6], q[7]);
                *(v2u*)(Yq + (size_t)(seq0 + tl0 + sub * 8 + j) * LD8 + col) = w; }
        }
#undef POOL_LOAD
    }
    __syncthreads();
}

__device__ __forceinline__ void final_norm_phase(Frame& F) {
    const int gw = F.vcu * NWAVES + F.wave, NGW = F.G * NWAVES;
    v2u raw[16];
    if (gw < M_TOK) { const bf16* xr = F.X2 + (size_t)gw * D;
#pragma unroll
        for (int q = 0; q < 16; ++q) raw[q] = *(const v2u*)(xr + q * 256 + F.lane * 4); }
    for (int row = gw; row < M_TOK; row += NGW) {
        float* yr = F.out + OFF_Y + (size_t)row * D;
        f32x4 v[16]; float ss = 0.f;
#pragma unroll
        for (int q = 0; q < 16; ++q) { const v2u w = raw[q]; v[q] = (f32x4){bflo(w.x), bfhi(w.x), bflo(w.y), bfhi(w.y)}; ss += (v[q].x * v[q].x + v[q].y * v[q].y) + (v[q].z * v[q].z + v[q].w * v[q].w); }
        if (row + NGW < M_TOK) { const bf16* xn = F.X2 + (size_t)(row + NGW) * D;
#pragma unroll
            for (int q = 0; q < 16; ++q) raw[q] = *(const v2u*)(xn + q * 256 + F.lane * 4); }
        const float rstd = rsqrtf(wave_sum(ss) * (1.0f / D) + NORM_EPS);
#pragma unroll
        for (int q = 0; q < 16; ++q) { const int c = q * 256 + F.lane * 4; const f32x4 g = *(const f32x4*)(F.final_g + c); *(f32x4*)(yr + c) = v[q] * rstd * g; }
    }
}

constexpr int N_PHASES = 12;
constexpr int N_LAUNCHES = MK_N_LAUNCHES;
struct Args { const float* in[20]; float* out; unsigned char* ws; int ph_lo, ph_hi; };
static_assert(sizeof(Args) == 20 * 8 + 8 + 8 + 8, "Args has no padding");
__global__ void __launch_bounds__(NTHREADS, 2) fwd_kernel(Args args) {
    extern __shared__ __attribute__((aligned(16))) unsigned char lds[];
    Frame F;
    F.lds = (LAS unsigned char*)lds;
    F.MISC = (volatile LAS unsigned*)(F.lds + MISC_OFF);
    F.tid = threadIdx.x; F.lane = F.tid & 63; F.wave = __builtin_amdgcn_readfirstlane(F.tid >> 6);
    F.G = gridDim.x; { const int bx = blockIdx.x; F.vcu = (F.G % 8 == 0) ? (bx % 8) * (F.G / 8) + bx / 8 : bx; }
    unsigned char* ws = args.ws;
    F.ctl = (gu32*)(ws + WS_CTL);
    F.x_prompt = args.in[0]; F.x_sample = args.in[1]; F.c_lat = args.in[2]; F.cache_ak = args.in[3]; F.cache_av = args.in[4]; F.cache_bk = args.in[5]; F.cache_bv = args.in[6];
    F.c_ctx = args.in[7]; F.w_ada = args.in[8]; F.b_ada = args.in[9]; F.norm_g = args.in[10]; F.w_in_attn = args.in[11]; F.a_sink = args.in[12]; F.b_rpb = args.in[13];
    F.w_out_attn = args.in[14]; F.w_in_pool = args.in[15]; F.w_grp = args.in[16]; F.pool_scale = args.in[17]; F.w_out_pool = args.in[18]; F.final_g = args.in[19];
    F.out = args.out;
    F.modp = (float*)(ws + WS_MODP); F.modf = (float*)(ws + WS_MODF); F.X1 = (bf16*)(ws + WS_X1); F.X2 = (bf16*)(ws + WS_X2); F.sA1 = (float*)(ws + WS_SCL); F.sW = F.sA1 + M_TOK; F.sW2 = F.sW + NPIN; F.Wq = ws + WS_WQ; F.Wq2 = ws + WS_WQ2;
    F.Wt_in = (bf16*)(ws + WS_WIN); F.Wt_kv = (bf16*)(ws + WS_WKV); F.H16 = (bf16*)(ws + WS_H16); F.Wt_out = (bf16*)(ws + WS_WOUT); F.Wt_pin = (bf16*)(ws + WS_WPIN); F.Wt_grp = (bf16*)(ws + WS_WGRP); F.Wt_pout = (bf16*)(ws + WS_WPOUT); F.Wu = (bf16*)(ws + WS_WU);
    F.cak = (bf16*)(ws + WS_CAK); F.cav = (bf16*)(ws + WS_CAV); F.cbk = (bf16*)(ws + WS_CBK); F.cbv = (bf16*)(ws + WS_CBV);
    F.rope_tab = (float*)(ws + WS_ROPE);
    F.H = (bf16*)(ws + WS_H); F.QKVG = (bf16*)(ws + WS_QKVG); F.ATT = (bf16*)(ws + WS_ATT);
    for (int u = F.tid; u < (LDS_BYTES - LDSCTL_OFF) / 4; u += NTHREADS) ((LAS unsigned*)(F.lds + LDSCTL_OFF))[u] = 0u;
    __syncthreads();
    XcdBarrier bar; bar.bar = (unsigned*)(F.ctl + CW_BAR); bar.x = 0; bar.st = nullptr;
    if (N_LAUNCHES == 1) bar = xcd_barrier_post((unsigned*)(F.ctl + CW_BAR), F.MISC + 8);
#define GRID_BAR() do { if (N_LAUNCHES == 1) xcd_barrier(bar); } while (0)
    const int lo = args.ph_lo, hi = args.ph_hi;
#define REFRESH() do { int t_ = threadIdx.x; asm volatile("" : "+v"(t_)); F.tid = t_; F.lane = t_ & 63; F.wave = __builtin_amdgcn_readfirstlane(t_ >> 6); } while (0)
#ifndef PROBE_REP
#define PROBE_REP -1
#endif
#ifndef PROBE_ATT_LIMIT
#define PROBE_ATT_LIMIT 1024
#endif
#define IN(k) (lo <= (k) && (k) < hi)
#define REPS(k) for (int rep_ = 0; rep_ < ((k) == PROBE_REP ? 2 : 1); ++rep_)
#define BOTH(k) (IN(k) && IN((k) + 1))
    typedef pg8::bf16_t pb;

    if (IN(0)) REPS(0) { REFRESH(); if (rep_) GRID_BAR(); p0_prologue(F); if (BOTH(0)) GRID_BAR(); }
    if (IN(1)) REPS(1) { REFRESH(); if (rep_) GRID_BAR(); p1_extras(F); norm0_phase(F);
        {
            pg8::Gemm g{(const pb*)F.Wt_grp, (const pb*)F.Wu, D, D, 1024, LDG, LDA, 0, 4}; pg8::StaticOrder S; S.init(D, D, F.G, (int)blockIdx.x);
            pg8::EpiBf16 E{(pb*)F.Wt_pin, LDA, 128, 1.0f};
            pg8::gemm_phase<pg8::EpiBf16, pg8::StaticOrder, true, true>(F.lds + RING_OFF, g, S, E);
        }
        if (BOTH(1)) GRID_BAR(); }
    if (IN(2)) REPS(2) { REFRESH(); if (rep_) GRID_BAR();
        for (int e = F.tid; e < 4096; e += NTHREADS) ((LAS float*)(F.lds + ROPE_LDS_OFF))[(e >> 5) * pg8::ROPE_LD + (e & 31)] = F.rope_tab[e];
        __syncthreads();
        {
            pg8::Gemm g{(const pb*)F.H16, (const pb*)F.Wt_kv, NCTX, 5120, D, LDA, LDA, 0, 0}; pg8::StaticOrder S; S.init(NCTX, 5120, F.G, F.G - 1 - (int)blockIdx.x);
            pg8::EpiKV E{(pb*)F.QKVG, HD, QBLK_STRIDE, F.out + OFF_NAK, F.out + OFF_NAV, F.out + OFF_NBK, F.out + OFF_NBV};
            pg8::gemm_phase<pg8::EpiKV, pg8::StaticOrder, true, true>(F.lds + RING_OFF, g, S, E);
        }
        {
            pg8::Gemm g{(const pb*)F.H, (const pb*)F.Wt_in, M_TOK, NIN, D, LD8, LD8, 0, 0}; pg8::MixedOrder S; S.init(F.G, (int)blockIdx.x);
            pg8::EpiQKVG E{(pb*)F.QKVG, HD, QBLK_STRIDE, 1.0f / (S8_H * S8_W), (const PG8_LAS float*)(F.lds + ROPE_LDS_OFF)};
            pg8::gemm_phase<pg8::EpiQKVG, pg8::MixedOrder, true, true, 1>(F.lds + RING_OFF, g, S, E);
        }
#ifndef PROBE_SIDE
#define PROBE_SIDE 1
#endif
        if (F.G == 256 && blockIdx.x >= 128) { REFRESH(); for (int sj_ = 0; sj_ < PROBE_SIDE; ++sj_) side_jobs(F, ((int)blockIdx.x - 128) * NWAVES + F.wave, 128 * NWAVES); }
        if (BOTH(2)) GRID_BAR();
    }
    if (IN(3) && F.G != 256) { REFRESH(); side_jobs(F, F.vcu * NWAVES + F.wave, F.G * NWAVES); if (BOTH(3)) GRID_BAR(); }
    if (IN(4)) REPS(4) { REFRESH(); if (rep_) GRID_BAR(); attn_phase(F, (char*)lds + RING_OFF, rep_ ? PROBE_ATT_LIMIT : 1024); if (BOTH(4)) GRID_BAR(); }
    if (IN(5)) REPS(5) { REFRESH(); if (rep_) GRID_BAR();
        pg8::Gemm g{(const pb*)F.ATT, (const pb*)F.Wt_out, M_TOK, D, D, LD8, LD8, 0, 0}; pg8::StaticOrder S; S.init(M_TOK, D, F.G, (int)blockIdx.x);
        typedef pg8::EpiResT<float, pb, false> Epi2;
        Epi2 E{F.x_prompt, F.x_sample, (pb*)F.X1, D, F.modf + 2 * D, 1.0f / (S8_W * S8_ATT), nullptr, nullptr};
        pg8::gemm_phase<Epi2, pg8::StaticOrder, true, true, 1>(F.lds + RING_OFF, g, S, E);
        if (BOTH(5)) GRID_BAR();
    }
    if (IN(6)) REPS(6) { REFRESH(); if (rep_) GRID_BAR(); norm1_phase(F); if (BOTH(6)) GRID_BAR(); }
    if (IN(7)) REPS(7) { REFRESH(); if (rep_) GRID_BAR();
        pg8::Gemm g{(const pb*)F.H, (const pb*)F.Wq, M_TOK, NPIN, D, LD8, LD8, 0, 0}; pg8::StaticOrder S; S.init(M_TOK, NPIN, F.G, (int)blockIdx.x);
        pg8::EpiI8 E{(pb*)F.QKVG, NPIN, F.sA1, F.sW};
        pg8::gemm_phase<pg8::EpiI8, pg8::StaticOrder, true, true, 2>(F.lds + RING_OFF, g, S, E);
        if (BOTH(7)) GRID_BAR();
    }
    if (IN(8)) REPS(8) { REFRESH(); if (rep_) GRID_BAR(); pool_phase(F); if (BOTH(8)) GRID_BAR(); }
    if (IN(10)) REPS(10) { REFRESH(); if (rep_) GRID_BAR();
        pg8::Gemm g{(const pb*)F.ATT, (const pb*)F.Wq2, M_TOK, D, D, LD8, LD8, 0, 0}; pg8::StaticOrder S; S.init(M_TOK, D, F.G, (int)blockIdx.x);
        typedef pg8::EpiResT<pb, pb, true> Epi5;
        Epi5 E{(const pb*)F.X1, (const pb*)F.X1 + (size_t)NCTX * D, (pb*)F.X2, D, F.modf + (size_t)NCOND * NMOD + 2 * D, 1.0f, F.sA1, F.sW2};
        pg8::gemm_phase<Epi5, pg8::StaticOrder, true, true, 2>(F.lds + RING_OFF, g, S, E);
        if (BOTH(10)) GRID_BAR();
    }
    if (IN(11)) REPS(11) { REFRESH(); if (rep_) GRID_BAR(); final_norm_phase(F); }
#undef IN
#undef REPS
#undef REFRESH
#undef BOTH
#undef GRID_BAR
}

extern "C" void kernel_launch(void* const* d_in, const int* in_sizes, int n_in, void* d_out, int out_size, void* d_ws, size_t ws_size, hipStream_t stream) {
    static int grid = 0;
    if (grid == 0) {
        if (n_in != 20 || (size_t)out_size != OUT_TOTAL || ws_size < WS_END) { fprintf(stderr, "kernel_launch: unexpected shapes: n_in %d out %d ws %zu (need %zu)\n", n_in, out_size, ws_size, (size_t)WS_END); grid = -1; return; }
        int dev = 0, cus = 0, per_cu = 0;
        if (hipGetDevice(&dev) != hipSuccess || hipDeviceGetAttribute(&cus, hipDeviceAttributeMultiprocessorCount, dev) != hipSuccess) { grid = -1; return; }
        if (hipFuncSetAttribute((const void*)fwd_kernel, hipFuncAttributeMaxDynamicSharedMemorySize, LDS_BYTES) != hipSuccess) { fprintf(stderr, "kernel_launch: hipFuncSetAttribute failed\n"); grid = -1; return; }
        if (hipOccupancyMaxActiveBlocksPerMultiprocessor(&per_cu, (const void*)fwd_kernel, NTHREADS, LDS_BYTES) != hipSuccess || per_cu < 1) fprintf(stderr, "kernel_launch: occupancy query says %d\n", per_cu);
        (void)hipGetLastError();
        grid = cus;
    }
    if (grid < 0) return;
    if (hipMemsetAsync((char*)d_ws + WS_CTL, 0, CTL_ZERO_BYTES, stream) != hipSuccess) return;
    Args a{};
    for (int i = 0; i < 20; ++i) a.in[i] = (const float*)d_in[i];
    a.out = (float*)d_out; a.ws = (unsigned char*)d_ws;
    if (N_LAUNCHES == 1) { a.ph_lo = 0; a.ph_hi = N_PHASES; hipLaunchKernelGGL(fwd_kernel, dim3(grid), dim3(NTHREADS), LDS_BYTES, stream, a); }
    else for (int p = 0; p < N_PHASES; ++p) { a.ph_lo = p; a.ph_hi = p + 1; hipLaunchKernelGGL(fwd_kernel, dim3(grid), dim3(NTHREADS), LDS_BYTES, stream, a); }
    const hipError_t le = hipPeekAtLastError();
    if (le != hipSuccess) fprintf(stderr, "kernel_launch: launch failed: %s\n", hipGetErrorName(le));
}
```
